# Optimizing an MI355X kernel written in HIP

```python
import math
import jax, jax.numpy as jnp
from jax import lax
import numpy as np

D_MODEL = 4096
BATCH = 2
SEQ = 8192
DEPTH = 1

N_MEM = 256
BLK = 128
EPS = 1e-6
NEG = -1e30
SB_HEADS = 16
SB_DH = 128
SB_W = SB_HEADS * SB_DH
MLA_HEADS = 16
MLA_Q_RANK = 1024
MLA_KV_RANK = 512
MLA_NOPE = 128
MLA_ROPE = 64
MLA_DV = 128
ROPE_BASE = 10000.0
MEM_HEADS = 4
MEM_DH = 512
MEM_W = MEM_HEADS * MEM_DH
N_BRANCH = 3
BRANCH_W = 2048
COLS_SB = 3 * SB_W
COLS_DQ = MLA_Q_RANK
COLS_DKV = MLA_KV_RANK + MLA_ROPE
COLS_MEMQ = MEM_W
COLS_GATE = N_BRANCH * D_MODEL
IN_COLS = COLS_SB + COLS_DQ + COLS_DKV + COLS_MEMQ + COLS_GATE
PEER_HEADS = 8
PEER_NKEYS = 128
PEER_N = PEER_NKEYS * PEER_NKEYS
PEER_DK = 256
PEER_TOPK = 16
PEER_CHUNK = 128

kernel_name = "hybrid_sb_mla_mem_peer_layer"


def rmsnorm(x, g):
    xf = x.astype(jnp.float32)
    y = xf * lax.rsqrt(jnp.mean(xf * xf, axis=-1, keepdims=True) + EPS)
    return (y * g.astype(jnp.float32)).astype(x.dtype)


def apply_rope(t, cos, sin):
    half = MLA_ROPE // 2
    t1, t2 = t[..., :half], t[..., half:]
    out = jnp.concatenate([t1 * cos - t2 * sin, t1 * sin + t2 * cos], axis=-1)
    return out.astype(t.dtype)


def to_blocks(t):
    b, h, s, d = t.shape
    return t.reshape(b, h, s // BLK, BLK, d).transpose(2, 0, 1, 3, 4)


def from_blocks(o):
    n, b, h, l, d = o.shape
    return o.transpose(1, 0, 3, 2, 4).reshape(b, n * l, h * d)


def stick_breaking_attention(q, k, v):
    s_len, d = k.shape[2], k.shape[3]
    scale = 1.0 / math.sqrt(d)
    kpos = jnp.arange(s_len)

    def block(args):
        qb, bi = args
        qpos = bi * BLK + jnp.arange(BLK)
        z = jnp.einsum('bhqd,bhkd->bhqk', qb, k).astype(jnp.float32) * scale
        strict = kpos[None, :] < qpos[:, None]
        log_keep = jnp.where(strict, jax.nn.log_sigmoid(-z), 0.0)
        after = jnp.sum(log_keep, axis=-1, keepdims=True) - jnp.cumsum(log_keep, axis=-1)
        w = jnp.where(strict, jnp.exp(jax.nn.log_sigmoid(z) + after), 0.0)
        return jnp.einsum('bhqk,bhkd->bhqd', w.astype(v.dtype), v)

    o = lax.map(block, (to_blocks(q), jnp.arange(s_len // BLK)))
    return from_blocks(o)


def mla_attention(q_nope, q_rope, k_nope, k_rope, v):
    s_len = k_nope.shape[2]
    scale = 1.0 / math.sqrt(MLA_NOPE + MLA_ROPE)
    kpos = jnp.arange(s_len)

    def block(args):
        qn, qr, bi = args
        qpos = bi * BLK + jnp.arange(BLK)
        s = (jnp.einsum('bhqd,bhkd->bhqk', qn, k_nope)
             + jnp.einsum('bhqr,bkr->bhqk', qr, k_rope)).astype(jnp.float32) * scale
        causal = kpos[None, :] <= qpos[:, None]
        p = jax.nn.softmax(jnp.where(causal, s, NEG), axis=-1)
        return jnp.einsum('bhqk,bhkd->bhqd', p.astype(v.dtype), v)

    o = lax.map(block, (to_blocks(q_nope), to_blocks(q_rope), jnp.arange(s_len // BLK)))
    return from_blocks(o)


def memory_attention(mq, mem_n, w_mem_kv):
    b, m, _ = mem_n.shape
    mkv = (mem_n @ w_mem_kv).reshape(b, m, 2, MEM_HEADS, MEM_DH)
    mk, mv = mkv[:, :, 0], mkv[:, :, 1]
    s = jnp.einsum('bshd,bmhd->bhsm', mq, mk).astype(jnp.float32) / math.sqrt(MEM_DH)
    p = jax.nn.softmax(s, axis=-1)
    o = jnp.einsum('bhsm,bmhd->bshd', p.astype(mv.dtype), mv)
    return o.reshape(mq.shape[0], mq.shape[1], MEM_W)


def peer_ffn(xn, w_q, sub_keys, u_tab, v_tab):
    b, s, d = xn.shape
    t = b * s

    def chunk(xc):
        c = xc.shape[0]
        q = (xc @ w_q).reshape(c, PEER_HEADS, 2, PEER_DK // 2)
        sc = jnp.einsum('thpd,hpnd->thpn', q, sub_keys)
        vals, idx = lax.top_k(sc, PEER_TOPK)
        cand = (vals[:, :, 0, :, None] + vals[:, :, 1, None, :]).reshape(c, PEER_HEADS, PEER_TOPK * PEER_TOPK)
        cidx = (idx[:, :, 0, :, None] * PEER_NKEYS + idx[:, :, 1, None, :]).reshape(c, PEER_HEADS, PEER_TOPK * PEER_TOPK)
        top, pos = lax.top_k(cand, PEER_TOPK)
        expert = jnp.take_along_axis(cidx, pos, axis=-1)
        g = jax.nn.softmax(top.astype(jnp.float32), axis=-1).astype(xc.dtype)
        u = jnp.take(u_tab, expert, axis=0)
        vv = jnp.take(v_tab, expert, axis=0)
        a = jax.nn.gelu(jnp.einsum('td,thkd->thk', xc, u), approximate=False) * g
        return jnp.einsum('thk,thkd->td', a, vv)

    y = lax.map(chunk, xn.reshape(t // PEER_CHUNK, PEER_CHUNK, d))
    return y.reshape(b, s, d)


def hybrid_layer(h, mem, cos, sin, g_mix, w_in, mla_g_q, mla_w_uq, mla_g_kv, mla_w_ukv,
                 g_mem, w_mem_kv, w_branch, w_out, g_ffn, peer_w_q, peer_sub_keys, peer_u, peer_v):
    b, s, d = h.shape
    xn = rmsnorm(h, g_mix)
    proj = xn @ w_in
    c1 = COLS_SB
    c2 = c1 + COLS_DQ
    c3 = c2 + COLS_DKV
    c4 = c3 + COLS_MEMQ
    sb_qkv, dq, dkv, mem_q, gate_logits = jnp.split(proj, [c1, c2, c3, c4], axis=-1)

    qkv = sb_qkv.reshape(b, s, 3, SB_HEADS, SB_DH).transpose(2, 0, 3, 1, 4)
    y_sb = stick_breaking_attention(qkv[0], qkv[1], qkv[2])

    c_q = rmsnorm(dq, mla_g_q)
    q = (c_q @ mla_w_uq).reshape(b, s, MLA_HEADS, MLA_NOPE + MLA_ROPE)
    q_nope = q[..., :MLA_NOPE]
    q_rope = apply_rope(q[..., MLA_NOPE:], cos[:, :, None, :], sin[:, :, None, :])
    c_kv = rmsnorm(dkv[..., :MLA_KV_RANK], mla_g_kv)
    k_rope = apply_rope(dkv[..., MLA_KV_RANK:], cos, sin)
    kv = (c_kv @ mla_w_ukv).reshape(b, s, MLA_HEADS, MLA_NOPE + MLA_DV)
    k_nope, v = kv[..., :MLA_NOPE], kv[..., MLA_NOPE:]
    y_mla = mla_attention(q_nope.transpose(0, 2, 1, 3), q_rope.transpose(0, 2, 1, 3),
                          k_nope.transpose(0, 2, 1, 3), k_rope, v.transpose(0, 2, 1, 3))

    y_mem = memory_attention(mem_q.reshape(b, s, MEM_HEADS, MEM_DH), rmsnorm(mem, g_mem), w_mem_kv)

    gates = jax.nn.sigmoid(gate_logits.astype(jnp.float32)).astype(h.dtype).reshape(b, s, N_BRANCH, d)
    merged = (gates[:, :, 0] * (y_sb @ w_branch[0])
              + gates[:, :, 1] * (y_mla @ w_branch[1])
              + gates[:, :, 2] * (y_mem @ w_branch[2]))
    h = h + merged @ w_out

    h = h + peer_ffn(rmsnorm(h, g_ffn), peer_w_q, peer_sub_keys, peer_u, peer_v)
    return h


def setup_inputs(seed: int = 0) -> dict:
    key = jax.random.key(seed)
    ks = jax.random.split(key, 24)
    f32 = jnp.float32

    def nrm(k, shape, scale):
        return jax.random.normal(k, shape, f32) * scale

    def gain(k, n):
        return 1.0 + 0.02 * jax.random.normal(k, (DEPTH, n), f32)

    x = jax.random.normal(ks[0], (BATCH, SEQ, D_MODEL), f32)
    mem = jax.random.normal(ks[1], (BATCH, N_MEM, D_MODEL), f32)
    offsets = jax.random.randint(ks[2], (BATCH, 1), 0, 1024, dtype=jnp.int32)
    positions = offsets + jnp.arange(SEQ, dtype=jnp.int32)[None, :]
    return {
        "x": x,
        "mem": mem,
        "positions": positions,
        "g_mix": gain(ks[3], D_MODEL),
        "w_in": nrm(ks[4], (DEPTH, D_MODEL, IN_COLS), D_MODEL ** -0.5),
        "mla_g_q": gain(ks[5], MLA_Q_RANK),
        "mla_w_uq": nrm(ks[6], (DEPTH, MLA_Q_RANK, MLA_HEADS * (MLA_NOPE + MLA_ROPE)), MLA_Q_RANK ** -0.5),
        "mla_g_kv": gain(ks[7], MLA_KV_RANK),
        "mla_w_ukv": nrm(ks[8], (DEPTH, MLA_KV_RANK, MLA_HEADS * (MLA_NOPE + MLA_DV)), MLA_KV_RANK ** -0.5),
        "g_mem": gain(ks[9], D_MODEL),
        "w_mem_kv": nrm(ks[10], (DEPTH, D_MODEL, 2 * MEM_W), D_MODEL ** -0.5),
        "w_branch": nrm(ks[11], (DEPTH, N_BRANCH, BRANCH_W, D_MODEL), BRANCH_W ** -0.5),
        "w_out": nrm(ks[12], (DEPTH, D_MODEL, D_MODEL), D_MODEL ** -0.5),
        "g_ffn": gain(ks[13], D_MODEL),
        "peer_w_q": nrm(ks[14], (DEPTH, D_MODEL, PEER_HEADS * PEER_DK), D_MODEL ** -0.5),
        "peer_sub_keys": nrm(ks[15], (DEPTH, PEER_HEADS, 2, PEER_NKEYS, PEER_DK // 2), (PEER_DK // 2) ** -0.5),
        "peer_u": nrm(ks[16], (DEPTH, PEER_N, D_MODEL), D_MODEL ** -0.5),
        "peer_v": nrm(ks[17], (DEPTH, PEER_N, D_MODEL), 0.5),
        "g_final": 1.0 + 0.02 * jax.random.normal(ks[18], (D_MODEL,), f32),
    }


def reference(x, mem, positions, g_mix, w_in, mla_g_q, mla_w_uq, mla_g_kv, mla_w_ukv,
              g_mem, w_mem_kv, w_branch, w_out, g_ffn, peer_w_q, peer_sub_keys, peer_u, peer_v, g_final):
    half = MLA_ROPE // 2
    freqs = ROPE_BASE ** (-jnp.arange(half, dtype=jnp.float32) / half)
    ang = positions.astype(jnp.float32)[..., None] * freqs
    cos, sin = jnp.cos(ang), jnp.sin(ang)
    h = x
    for layer in range(DEPTH):
        h = hybrid_layer(h, mem, cos, sin, g_mix[layer], w_in[layer], mla_g_q[layer], mla_w_uq[layer],
                         mla_g_kv[layer], mla_w_ukv[layer], g_mem[layer], w_mem_kv[layer],
                         w_branch[layer], w_out[layer], g_ffn[layer], peer_w_q[layer],
                         peer_sub_keys[layer], peer_u[layer], peer_v[layer])
    return rmsnorm(h, g_final)
```

```cpp
#include <hip/hip_runtime.h>
#include <cstdio>
#include <cstdint>

#ifndef N_LAUNCHES
#define N_LAUNCHES 1
#endif

#define LAS __attribute__((address_space(3)))
#define GAS __attribute__((address_space(1)))
typedef unsigned short bf16_t;
typedef short bf16x8 __attribute__((ext_vector_type(8)));
typedef short s16x4 __attribute__((ext_vector_type(4)));
typedef float f32x4 __attribute__((ext_vector_type(4)));
typedef float f32x2 __attribute__((ext_vector_type(2)));
typedef float f32x16 __attribute__((ext_vector_type(16)));
typedef unsigned u32x4 __attribute__((ext_vector_type(4)));
typedef unsigned u32x2 __attribute__((ext_vector_type(2)));
typedef __bf16 bf2_t __attribute__((ext_vector_type(2)));
typedef int i32x4 __attribute__((ext_vector_type(4)));
typedef int i32x8 __attribute__((ext_vector_type(8)));

constexpr int T = 16384, SEQ = 8192, D = 4096;
constexpr int NPROJ = 22272;
constexpr int IN_COLS = 22080;
constexpr int NEXP = 16384;
constexpr float EPS = 1e-6f;
constexpr float LOG2E = 1.4426950408889634f;
constexpr float C_SB = LOG2E * 0.08838834764831845f;
constexpr float C_MLA = LOG2E * 0.07216878364870322f;
constexpr float C_MEM = LOG2E * 0.04419417382415922f;
constexpr float SB_DONE = -160.f;
constexpr float WG8_SC = 64.f;
constexpr float YB_SC = 16.f, YC_SC = 8.f, WBR_SC = 32.f, MG_SC = 4.f, WOUT_SC = 64.f;
constexpr int NPROJ_BF = 7936, NGATE = 12288, NPROJ_F8 = 2048 + NGATE;
constexpr float H8_SC = 8.f;
constexpr float A8_SC = 64.f;
constexpr float PEER_SCU = 1024.f, PEER_SCV = 16.f;

constexpr size_t MiB = 1u << 20;
constexpr size_t WS_CTL = 0, CTL_ZERO_BYTES = 1 * MiB;
constexpr size_t WS_RS = 1 * MiB;
constexpr size_t WS_SSQ_DQ = 1 * MiB + 512 * 1024;
constexpr size_t WS_SSQ_DKV = 2 * MiB + 512 * 1024;
constexpr size_t WS_SSQ_H = 3 * MiB;
constexpr size_t WS_CS = 8 * MiB;
constexpr size_t WS_MEMN = 12 * MiB;
constexpr size_t WS_MK = 16 * MiB;
constexpr size_t WS_MVT = 18 * MiB;
constexpr size_t WS_SKB = 20 * MiB;
constexpr size_t WS_WUQ = 22 * MiB;
constexpr size_t WS_WUKV = 28 * MiB;
constexpr size_t WS_WMKV = 32 * MiB;
constexpr size_t WS_WBR = 64 * MiB;
constexpr size_t WS_WOUT = 112 * MiB;
constexpr size_t WS_WPQ = 144 * MiB;
constexpr size_t WS_YMLA = 160 * MiB;
constexpr size_t WS_R0 = 224 * MiB;
constexpr size_t WS_XB = WS_R0;
constexpr size_t WS_WIN = WS_R0 + 128 * MiB;
constexpr size_t WS_QMLA = WS_R0;
constexpr size_t WS_KF = WS_R0 + 96 * MiB;
constexpr size_t WS_VV = WS_R0 + 192 * MiB;
constexpr size_t WS_H1B = WS_R0;
constexpr size_t WS_ROUTE = WS_R0 + 128 * MiB;
constexpr size_t WS_R1 = 526 * MiB;
constexpr size_t WS_SBQ = WS_R1;
constexpr size_t WS_SBK = WS_R1 + 64 * MiB;
constexpr size_t WS_SBV = WS_R1 + 128 * MiB;
constexpr size_t WS_DQ = WS_R1 + 192 * MiB;
constexpr size_t WS_DKV = WS_R1 + 224 * MiB;
constexpr size_t WS_MEMQ = WS_R1 + 248 * MiB;
constexpr size_t WS_GATES = WS_R1 + 312 * MiB;
constexpr size_t WS_MERGED = WS_SBK;
constexpr size_t WS_PQ = WS_SBQ;
constexpr size_t WS_UTAB = WS_GATES;
constexpr size_t WS_VTAB = WS_GATES + 128 * MiB;
constexpr size_t WS_SMEM = WS_GATES + 384 * MiB;
constexpr size_t WS_END = WS_SMEM + 64 * MiB;
constexpr size_t WS_XB8 = WS_END;
constexpr size_t WS_WIN8 = WS_R0 + 206 * MiB;
constexpr size_t WS_END2 = WS_XB8 + 64 * MiB;
constexpr size_t WS_Y8A = WS_XB8;
constexpr size_t WS_Y8B = WS_XB8 + 32 * MiB;
constexpr size_t WS_Y8C = WS_YMLA;
constexpr size_t WS_MG8 = WS_R0 + 128 * MiB;

constexpr int NWAVES = 8, NTHREADS = 512;
constexpr int LDS_BYTES = 163840;
constexpr int MISC_OFF = LDS_BYTES - 64;

__device__ __forceinline__ unsigned cvt_pk_bf16(float lo, float hi) { unsigned r; asm volatile("v_cvt_pk_bf16_f32 %0, %1, %2" : "=v"(r) : "v"(lo), "v"(hi)); return r; }
__device__ __forceinline__ float bf_lo(unsigned u) { return __uint_as_float(u << 16); }
__device__ __forceinline__ float bf_hi(unsigned u) { return __uint_as_float(u & 0xffff0000u); }
__device__ __forceinline__ float fexp2(float x) { return __builtin_amdgcn_exp2f(x); }
__device__ __forceinline__ float flog2(float x) { return __builtin_amdgcn_logf(x); }
__device__ __forceinline__ float frcp(float x) { return __builtin_amdgcn_rcpf(x); }
__device__ __forceinline__ float dot2_bf16(unsigned a, unsigned b, float acc) { return __builtin_amdgcn_fdot2_f32_bf16(__builtin_bit_cast(bf2_t, a), __builtin_bit_cast(bf2_t, b), acc, false); }
template <int CTRL> __device__ __forceinline__ float dpp_add(float x) { return x + __builtin_bit_cast(float, __builtin_amdgcn_update_dpp(0, __builtin_bit_cast(int, x), CTRL, 0xf, 0xf, false)); }
__device__ __forceinline__ float row16_sum(float x) { x = dpp_add<0x128>(x); x = dpp_add<0x141>(x); x = dpp_add<0x4E>(x); return dpp_add<0xB1>(x); }
__device__ __forceinline__ float xor32_max(float x) { const unsigned b = __float_as_uint(x); auto rr = __builtin_amdgcn_permlane32_swap(b, b, false, false); return fmaxf(__uint_as_float(rr[0]), __uint_as_float(rr[1])); }
__device__ __forceinline__ float xor32_sum(float x) { const unsigned b = __float_as_uint(x); auto rr = __builtin_amdgcn_permlane32_swap(b, b, false, false); return __uint_as_float(rr[0]) + __uint_as_float(rr[1]); }
__device__ __forceinline__ float xor32_partner(float x, int hi) { const unsigned b = __float_as_uint(x); auto rr = __builtin_amdgcn_permlane32_swap(b, b, false, false); return __uint_as_float(hi ? rr[0] : rr[1]); }
__device__ __forceinline__ float wave_sum(float v) {
#pragma unroll
    for (int o = 1; o < 64; o <<= 1) v += __shfl_xor(v, o);
    return v;
}
#define LDS_WAIT() asm volatile("s_waitcnt lgkmcnt(0)" ::: "memory")
#define VM_WAIT() asm volatile("s_waitcnt vmcnt(0)" ::: "memory")

namespace pg8 {
constexpr int BM = 256, BK = 64, HALF = 128, HTB = HALF * BK * 2, STAGE_BYTES = 8 * HTB, NXCD = 8, WGM = 8;
__host__ __device__ __forceinline__ int lds_byte(int r, int c) { const int st = (r >> 4) * 2 + (c >> 5), rr = r & 15, cc = c & 31, ob = rr * 64 + cc * 2; return st * 1024 + (ob ^ (((ob >> 9) & 1) << 5)); }
__host__ __device__ __forceinline__ void stage_rc(int b, int& R, int& C) { const int st = b / 1024, sb = b % 1024, swz = sb ^ (((sb >> 9) & 1) << 5); R = (st >> 1) * 16 + swz / 64; C = (st & 1) * 32 + (swz % 64) / 2; }
__host__ __device__ __forceinline__ int perm32(int rho) { const int n = rho >> 4, i = rho & 15; return 8 * (i >> 2) + 4 * n + (i & 3); }

struct Unit { int pm, pn, z; };
struct Gemm { int K, lda, ldb; };

__device__ __forceinline__ void tile_of(int wgid, int nM, int nN, int& pm, int& pn) {
    const int nwg = nM * nN;
    { const int q = nwg / NXCD, r = nwg % NXCD, xcd = wgid % NXCD, off = wgid / NXCD; wgid = (xcd < r ? xcd * (q + 1) : r * (q + 1) + (xcd - r) * q) + off; }
    const int nig = WGM * nN, gid = wgid / nig, fm = gid * WGM, gsz = (nM - fm) < WGM ? (nM - fm) : WGM;
    pm = fm + ((wgid % nig) % gsz); pn = (wgid % nig) / gsz;
}
struct SchedB {
    int nM, nN, nz, G, c; const char* A; const char* B; size_t tA, tB, zA, zB;
    __device__ __forceinline__ void init(int M, int N, int nz_, int G_, int c_, const void* A_, const void* B_, int lda, int ldb, size_t zA_, size_t zB_) {
        nM = M / BM; nN = N / BM; nz = nz_; G = G_; c = c_; A = (const char*)A_; B = (const char*)B_; tA = (size_t)BM * lda * 2; tB = (size_t)BM * ldb * 2; zA = zA_; zB = zB_; }
    __device__ __forceinline__ bool next(int i, Unit& u) const {
        const long L = (long)i * G + c; const int per = nM * nN; if (L >= (long)per * nz) return false;
        u.z = (int)(L / per); tile_of((int)(L % per), nM, nN, u.pm, u.pn); return true; }
    __device__ __forceinline__ const char* pa(const Unit& u) const { return A + (size_t)u.z * zA + (size_t)u.pm * tA; }
    __device__ __forceinline__ const char* pb(const Unit& u) const { return B + (size_t)u.z * zB + (size_t)u.pn * tB; }
};
struct SchedM {
    int nM, nN, G, c; const char* ws; const char* B; size_t tA, tB, zB; size_t o0, o1, o2;
    __device__ __forceinline__ bool next(int i, Unit& u) const {
        const long L = (long)(i / 3) * G + c; if (L >= (long)nM * nN) return false;
        u.z = i % 3; tile_of((int)L, nM, nN, u.pm, u.pn); return true; }
    __device__ __forceinline__ const char* pa(const Unit& u) const { const size_t off = (u.z == 0 ? (size_t)WS_Y8A : (u.z == 1 ? (size_t)WS_Y8B : (size_t)WS_Y8C)); return ws + off + (size_t)u.pm * tA; }
    __device__ __forceinline__ const char* pb(const Unit& u) const { return B + (size_t)u.z * zB + (size_t)u.pn * tB; }
};

template <class Epi, class Sched, bool ALIGN_EPI = true>
__device__ __forceinline__ void gemm_phase(LAS unsigned char* lds, const Gemm g, const Sched& S, const Epi& E) {
    const int tid = threadIdx.x, wid = __builtin_amdgcn_readfirstlane(tid >> 6), lane = tid & 63, wr = wid >> 2, wc = wid & 3, fr = lane & 15, fq = lane >> 4;
    const int K = g.K, nt = K / BK;
    unsigned voffA[2], voffB[2];
#pragma unroll
    for (int i = 0; i < 2; ++i) { int R, C; stage_rc(tid * 16 + i * 8192, R, C); const int Rb = Epi::PERM ? ((R & ~31) + perm32(R & 31)) : R;
        voffA[i] = (unsigned)(R * g.lda + C) * 2u; voffB[i] = (unsigned)(Rb * g.ldb + C) * 2u; }
    const size_t kstep = (size_t)(BK * 2);
    const size_t hsA = (size_t)HALF * g.lda * 2, hsB = (size_t)HALF * g.ldb * 2;
    const unsigned ldsw = (unsigned)wid * 1024u;
    const int aoff = lds_byte(wr * 64 + fr, fq * 8), boff = lds_byte(wc * 32 + fr, fq * 8);
#define PG8_SA(b, h) (((b) * 2 + (h)) * HTB)
#define PG8_SB(b, h) ((4 + (b) * 2 + (h)) * HTB)
#define PG8_STAGE(bufoff, gbase, voff) do { _Pragma("unroll") for (int _i = 0; _i < 2; ++_i) \
        __builtin_amdgcn_global_load_lds((const unsigned*)((const char*)(gbase) + (voff)[_i]), (LAS unsigned*)(lds + (bufoff) + ldsw + _i * 8192), 16, 0, 0); } while (0)
#define PG8_LDA(dst, b, h) do { _Pragma("unroll") for (int m = 0; m < 4; ++m) _Pragma("unroll") for (int k = 0; k < 2; ++k) dst[m][k] = *(const LAS bf16x8*)(lds + PG8_SA(b, h) + aoff + m * 2048 + k * 1024); } while (0)
#define PG8_LDB(dst, b, h) do { _Pragma("unroll") for (int n = 0; n < 2; ++n) _Pragma("unroll") for (int k = 0; k < 2; ++k) dst[n][k] = *(const LAS bf16x8*)(lds + PG8_SB(b, h) + boff + n * 2048 + k * 1024); } while (0)
#define PG8_MMA(ai, bj, At, Bt) do { __builtin_amdgcn_s_setprio(1); _Pragma("unroll") for (int m = 0; m < 4; ++m) _Pragma("unroll") for (int n = 0; n < 2; ++n) _Pragma("unroll") for (int k = 0; k < 2; ++k) \
        acc[ai][bj][m][n] = __builtin_amdgcn_mfma_f32_16x16x32_bf16(Bt[n][k], At[m][k], acc[ai][bj][m][n], 0, 0, 0); __builtin_amdgcn_s_setprio(0); } while (0)
#define PG8_WAIT_V(n) asm volatile("s_waitcnt vmcnt(" #n ")" ::: "memory")
#define PG8_WAIT_L(n) asm volatile("s_waitcnt lgkmcnt(" #n ")" ::: "memory")
#define PG8_BAR __builtin_amdgcn_s_barrier()
#define PG8_SCHED __builtin_amdgcn_sched_barrier(0)
    Unit cur, nxt; int ui = 0;
    if (!S.next(0, cur)) return;
    f32x4 acc[2][2][4][2];
#pragma unroll
    for (int a = 0; a < 2; ++a)
#pragma unroll
        for (int b = 0; b < 2; ++b)
#pragma unroll
            for (int m = 0; m < 4; ++m)
#pragma unroll
                for (int n = 0; n < 2; ++n) acc[a][b][m][n] = (f32x4){0.f, 0.f, 0.f, 0.f};
    bf16x8 At[4][2], B0[2][2], B1[2][2];
    const char* cA = S.pa(cur); const char* cB = S.pb(cur);
    PG8_STAGE(PG8_SB(0, 0), cB, voffB); PG8_STAGE(PG8_SB(0, 1), cB + hsB, voffB); PG8_STAGE(PG8_SA(0, 0), cA, voffA); PG8_STAGE(PG8_SA(0, 1), cA + hsA, voffA);
    if (wr == 1) PG8_BAR;
    PG8_WAIT_V(2); PG8_BAR;
    PG8_STAGE(PG8_SB(1, 0), cB + kstep, voffB); PG8_STAGE(PG8_SA(1, 0), cA + kstep, voffA); PG8_STAGE(PG8_SB(1, 1), cB + hsB + kstep, voffB);
    PG8_WAIT_V(6); PG8_BAR;
    for (;;) {
        const bool has_next = S.next(ui + 1, nxt);
        const char* nA = has_next ? S.pa(nxt) : cA; const char* nB = has_next ? S.pb(nxt) : cB;
        for (int t = 0; t < nt; t += 2) {
            const bool last = (t == nt - 2);
            const char* a1 = cA + (size_t)(t + 1) * kstep;
            const char* a2 = last ? nA : cA + (size_t)(t + 2) * kstep; const char* b2 = last ? nB : cB + (size_t)(t + 2) * kstep;
            const char* a3 = a2 + kstep; const char* b3 = b2 + kstep;
            PG8_LDB(B0, 0, 0); PG8_LDB(B1, 0, 1); PG8_SCHED; PG8_LDA(At, 0, 0); PG8_STAGE(PG8_SA(1, 1), a1 + hsA, voffA);
            PG8_WAIT_V(8); PG8_WAIT_L(0); PG8_BAR; PG8_MMA(0, 0, At, B0); PG8_MMA(0, 1, At, B1); PG8_BAR; PG8_SCHED;
            PG8_LDA(At, 0, 1); PG8_STAGE(PG8_SB(0, 0), b2, voffB); PG8_STAGE(PG8_SB(0, 1), b2 + hsB, voffB); PG8_STAGE(PG8_SA(0, 0), a2, voffA);
            PG8_WAIT_V(8); PG8_WAIT_L(0); PG8_BAR; PG8_MMA(1, 0, At, B0); PG8_MMA(1, 1, At, B1); PG8_BAR; PG8_SCHED;
            PG8_LDB(B0, 1, 0); PG8_LDB(B1, 1, 1); PG8_SCHED; PG8_LDA(At, 1, 0); PG8_STAGE(PG8_SA(0, 1), a2 + hsA, voffA);
            PG8_WAIT_V(8); PG8_WAIT_L(0); PG8_BAR; PG8_MMA(0, 0, At, B0); PG8_MMA(0, 1, At, B1); PG8_BAR; PG8_SCHED;
            PG8_LDA(At, 1, 1); PG8_STAGE(PG8_SB(1, 0), b3, voffB); PG8_STAGE(PG8_SB(1, 1), b3 + hsB, voffB); PG8_STAGE(PG8_SA(1, 0), a3, voffA);
            PG8_WAIT_V(8); PG8_WAIT_L(0); PG8_BAR; PG8_MMA(1, 0, At, B0); PG8_MMA(1, 1, At, B1); PG8_BAR; PG8_SCHED;
        }
        if constexpr (ALIGN_EPI) { if (wr == 0) PG8_BAR; }
        E(acc, cur, wr, wc, fr, fq);
        if (!has_next) break;
#pragma unroll
        for (int a = 0; a < 2; ++a)
#pragma unroll
            for (int b = 0; b < 2; ++b)
#pragma unroll
                for (int m = 0; m < 4; ++m)
#pragma unroll
                    for (int n = 0; n < 2; ++n) acc[a][b][m][n] = (f32x4){0.f, 0.f, 0.f, 0.f};
        cur = nxt; cA = nA; cB = nB; ++ui;
        if constexpr (ALIGN_EPI) { if (wr == 1) PG8_BAR; }
    }
    PG8_WAIT_V(0);
    if constexpr (!ALIGN_EPI) { if (wr == 0) PG8_BAR; }
    PG8_BAR;
#undef PG8_SA
#undef PG8_SB
#undef PG8_STAGE
#undef PG8_LDA
#undef PG8_LDB
#undef PG8_MMA
#undef PG8_WAIT_V
#undef PG8_WAIT_L
#undef PG8_BAR
#undef PG8_SCHED
}
__host__ __device__ __forceinline__ int sw8(int r) { return ((r >> 1) & 1) | (((r >> 3) & 1) << 2); }
template <class Epi, class Sched, bool ALIGN_EPI = true>
__device__ __forceinline__ void gemm_phase_f8(LAS unsigned char* lds, const Gemm g, const Sched& S, const Epi& E) {
    const int tid = threadIdx.x, wid = __builtin_amdgcn_readfirstlane(tid >> 6), lane = tid & 63, wr = wid >> 2, wc = wid & 3, fr = lane & 15, fq = lane >> 4;
    const int K = g.K, nt = K / 128;
    unsigned voffA[2], voffB[2];
#pragma unroll
    for (int i = 0; i < 2; ++i) { const int bb = tid * 16 + i * 8192, R = (bb >> 11) * 16 + ((bb >> 7) & 15), ch = ((bb >> 4) & 7) ^ sw8(R & 15); const int Rb = Epi::PERM ? ((R & ~31) + perm32(R & 31)) : R;
        voffA[i] = (unsigned)(R * g.lda + ch * 16); voffB[i] = (unsigned)(Rb * g.ldb + ch * 16); }
    const size_t kstep = (size_t)(BK * 2);
    const size_t hsA = (size_t)HALF * g.lda, hsB = (size_t)HALF * g.ldb;
    const unsigned ldsw = (unsigned)wid * 1024u;
    const int scl = 0x7f7f7f7f;
    const int aoff = (wr * 4) * 2048 + fr * 128, boff = (wc * 2) * 2048 + fr * 128, c0off = ((2 * fq) ^ sw8(fr)) * 16, c1off = ((2 * fq + 1) ^ sw8(fr)) * 16;
#define PG8_SA(b, h) (((b) * 2 + (h)) * HTB)
#define PG8_SB(b, h) ((4 + (b) * 2 + (h)) * HTB)
#define PG8_STAGE(bufoff, gbase, voff) do { _Pragma("unroll") for (int _i = 0; _i < 2; ++_i) \
        __builtin_amdgcn_global_load_lds((const unsigned*)((const char*)(gbase) + (voff)[_i]), (LAS unsigned*)(lds + (bufoff) + ldsw + _i * 8192), 16, 0, 0); } while (0)
#define PG8_LDA(dst, b, h) do { _Pragma("unroll") for (int m = 0; m < 4; ++m) { dst[m][0] = *(const LAS bf16x8*)(lds + PG8_SA(b, h) + aoff + m * 2048 + c0off); dst[m][1] = *(const LAS bf16x8*)(lds + PG8_SA(b, h) + aoff + m * 2048 + c1off); } } while (0)
#define PG8_LDB(dst, b, h) do { _Pragma("unroll") for (int n = 0; n < 2; ++n) { dst[n][0] = *(const LAS bf16x8*)(lds + PG8_SB(b, h) + boff + n * 2048 + c0off); dst[n][1] = *(const LAS bf16x8*)(lds + PG8_SB(b, h) + boff + n * 2048 + c1off); } } while (0)
#define PG8_F8(x) __builtin_shufflevector(__builtin_bit_cast(i32x4, x[0]), __builtin_bit_cast(i32x4, x[1]), 0, 1, 2, 3, 4, 5, 6, 7)
#define PG8_MMA(ai, bj, At, Bt) do { __builtin_amdgcn_s_setprio(1); _Pragma("unroll") for (int m = 0; m < 4; ++m) _Pragma("unroll") for (int n = 0; n < 2; ++n) \
        asm volatile("v_mfma_f32_16x16x128_f8f6f4 %0, %1, %2, %0" : "+v"(acc[ai][bj][m][n]) : "v"(PG8_F8(Bt[n])), "v"(PG8_F8(At[m]))); __builtin_amdgcn_s_setprio(0); } while (0)
#define PG8_WAIT_V(n) asm volatile("s_waitcnt vmcnt(" #n ")" ::: "memory")
#define PG8_WAIT_L(n) asm volatile("s_waitcnt lgkmcnt(" #n ")" ::: "memory")
#define PG8_BAR __builtin_amdgcn_s_barrier()
#define PG8_SCHED __builtin_amdgcn_sched_barrier(0)
    Unit cur, nxt; int ui = 0;
    if (!S.next(0, cur)) return;
    f32x4 acc[2][2][4][2];
#pragma unroll
    for (int a = 0; a < 2; ++a)
#pragma unroll
        for (int b = 0; b < 2; ++b)
#pragma unroll
            for (int m = 0; m < 4; ++m)
#pragma unroll
                for (int n = 0; n < 2; ++n) acc[a][b][m][n] = (f32x4){0.f, 0.f, 0.f, 0.f};
    bf16x8 At[4][2], B0[2][2], B1[2][2];
    const char* cA = S.pa(cur); const char* cB = S.pb(cur);
    PG8_STAGE(PG8_SB(0, 0), cB, voffB); PG8_STAGE(PG8_SB(0, 1), cB + hsB, voffB); PG8_STAGE(PG8_SA(0, 0), cA, voffA); PG8_STAGE(PG8_SA(0, 1), cA + hsA, voffA);
    if (wr == 1) PG8_BAR;
    PG8_WAIT_V(2); PG8_BAR;
    PG8_STAGE(PG8_SB(1, 0), cB + kstep, voffB); PG8_STAGE(PG8_SA(1, 0), cA + kstep, voffA); PG8_STAGE(PG8_SB(1, 1), cB + hsB + kstep, voffB);
    PG8_WAIT_V(6); PG8_BAR;
    for (;;) {
        const bool has_next = S.next(ui + 1, nxt);
        const char* nA = has_next ? S.pa(nxt) : cA; const char* nB = has_next ? S.pb(nxt) : cB;
        for (int t = 0; t < nt; t += 2) {
            const bool last = (t == nt - 2);
            const char* a1 = cA + (size_t)(t + 1) * kstep;
            const char* a2 = last ? nA : cA + (size_t)(t + 2) * kstep; const char* b2 = last ? nB : cB + (size_t)(t + 2) * kstep;
            const char* a3 = a2 + kstep; const char* b3 = b2 + kstep;
            PG8_LDB(B0, 0, 0); PG8_LDB(B1, 0, 1); PG8_SCHED; PG8_LDA(At, 0, 0); PG8_STAGE(PG8_SA(1, 1), a1 + hsA, voffA);
            PG8_WAIT_V(8); PG8_WAIT_L(0); PG8_BAR; PG8_MMA(0, 0, At, B0); PG8_MMA(0, 1, At, B1); PG8_BAR; PG8_SCHED;
            PG8_LDA(At, 0, 1); PG8_STAGE(PG8_SB(0, 0), b2, voffB); PG8_STAGE(PG8_SB(0, 1), b2 + hsB, voffB); PG8_STAGE(PG8_SA(0, 0), a2, voffA);
            PG8_WAIT_V(8); PG8_WAIT_L(0); PG8_BAR; PG8_MMA(1, 0, At, B0); PG8_MMA(1, 1, At, B1); PG8_BAR; PG8_SCHED;
            PG8_LDB(B0, 1, 0); PG8_LDB(B1, 1, 1); PG8_SCHED; PG8_LDA(At, 1, 0); PG8_STAGE(PG8_SA(0, 1), a2 + hsA, voffA);
            PG8_WAIT_V(8); PG8_WAIT_L(0); PG8_BAR; PG8_MMA(0, 0, At, B0); PG8_MMA(0, 1, At, B1); PG8_BAR; PG8_SCHED;
            PG8_LDA(At, 1, 1); PG8_STAGE(PG8_SB(1, 0), b3, voffB); PG8_STAGE(PG8_SB(1, 1), b3 + hsB, voffB); PG8_STAGE(PG8_SA(1, 0), a3, voffA);
            PG8_WAIT_V(8); PG8_WAIT_L(0); PG8_BAR; PG8_MMA(1, 0, At, B0); PG8_MMA(1, 1, At, B1); PG8_BAR; PG8_SCHED;
        }
        if constexpr (ALIGN_EPI) { if (wr == 0) PG8_BAR; }
        E(acc, cur, wr, wc, fr, fq);
        if (!has_next) break;
#pragma unroll
        for (int a = 0; a < 2; ++a)
#pragma unroll
            for (int b = 0; b < 2; ++b)
#pragma unroll
                for (int m = 0; m < 4; ++m)
#pragma unroll
                    for (int n = 0; n < 2; ++n) acc[a][b][m][n] = (f32x4){0.f, 0.f, 0.f, 0.f};
        cur = nxt; cA = nA; cB = nB; ++ui;
        if constexpr (ALIGN_EPI) { if (wr == 1) PG8_BAR; }
    }
    PG8_WAIT_V(0);
    if constexpr (!ALIGN_EPI) { if (wr == 0) PG8_BAR; }
    PG8_BAR;
#undef PG8_SA
#undef PG8_SB
#undef PG8_STAGE
#undef PG8_LDA
#undef PG8_LDB
#undef PG8_MMA
#undef PG8_F8
#undef PG8_WAIT_V
#undef PG8_WAIT_L
#undef PG8_BAR
#undef PG8_SCHED
}
}
using pg8::Unit;

typedef const f32x4 (&AccRef)[2][2][4][2];

__device__ __forceinline__ void store_bf16x8(bf16_t* p, f32x4 v0, f32x4 v1) {
    u32x4 w; w.x = cvt_pk_bf16(v0[0], v0[1]); w.y = cvt_pk_bf16(v0[2], v0[3]); w.z = cvt_pk_bf16(v1[0], v1[1]); w.w = cvt_pk_bf16(v1[2], v1[3]);
    *(u32x4*)p = w;
}

struct EpiProj {
    static constexpr bool PERM = true;
    const float* rs; bf16_t* sbq; bf16_t* dq; bf16_t* dkv; bf16_t* memq; bf16_t* gates; float* ssq_dq; float* ssq_dkv; int pn0; float gsc;
    __device__ __forceinline__ void operator()(AccRef acc, const Unit& u, int wr, int wc, int fr, int fq) const {
        const int pn = u.pn + pn0, row0 = u.pm * 256 + wr * 64 + fr, cl = wc * 32 + 8 * fq;
        bf16_t* base; int ldc; float cs = 1.f; int mode = 0; float* sq = nullptr; int ns = 0, slot = 0;
        if (pn < 24) { const int which = pn >> 3; base = sbq + (size_t)which * ((size_t)T * 2048) + (pn & 7) * 256; ldc = 2048; if (which == 0) cs = C_SB; }
        else if (pn < 28) { base = dq + (pn - 24) * 256; ldc = 1024; sq = ssq_dq; ns = 16; slot = (pn - 24) * 4 + wc; }
        else if (pn < 31) { base = dkv + (pn - 28) * 256; ldc = 768; if (pn < 30) { sq = ssq_dkv; ns = 8; slot = (pn - 28) * 4 + wc; } }
        else if (pn < 39) { base = memq + (pn - 31) * 256; ldc = 2048; cs = C_MEM * gsc; }
        else { base = gates + ((size_t)(u.pm * 48 + (pn - 39)) << 16); ldc = 0; mode = 1; cs = gsc; }
        const int bjs = mode == 1 ? 512 : 128;
        float rsv[8];
#pragma unroll
        for (int q = 0; q < 8; ++q) rsv[q] = rs[row0 + (q >> 2) * 128 + (q & 3) * 16];
#pragma unroll
        for (int ai = 0; ai < 2; ++ai)
#pragma unroll
            for (int m = 0; m < 4; ++m) {
                const int row = row0 + ai * 128 + m * 16; const float sc = rsv[ai * 4 + m] * cs; float s2 = 0.f;
                bf16_t* rowp = mode == 1 ? base + (size_t)(((((wr * 4 + wc) * 2 + ai) * 4 + m) * 2) * 64 + fq * 16 + fr) * 8 : base + (size_t)row * ldc + cl;
#pragma unroll
                for (int bj = 0; bj < 2; ++bj) {
                    f32x4 v0 = acc[ai][bj][m][0] * sc, v1 = acc[ai][bj][m][1] * sc;
                    if (mode == 1) {
#pragma unroll
                        for (int j = 0; j < 4; ++j) { v0[j] = frcp(1.f + fexp2(-LOG2E * v0[j])); v1[j] = frcp(1.f + fexp2(-LOG2E * v1[j])); }
                    }

                    s2 += (v0[0] * v0[0] + v0[1] * v0[1]) + (v0[2] * v0[2] + v0[3] * v0[3]) + (v1[0] * v1[0] + v1[1] * v1[1]) + (v1[2] * v1[2] + v1[3] * v1[3]);
                    store_bf16x8(rowp + bj * bjs, v0, v1);
                }
                if (sq) { s2 += __shfl_xor(s2, 16); s2 += __shfl_xor(s2, 32); if (fq == 0) sq[(size_t)row * ns + slot] = s2; }
            }
    }
};
struct EpiMemKV {
    static constexpr bool PERM = false;
    bf16_t* mk; bf16_t* mvt;
    __device__ __forceinline__ void operator()(AccRef acc, const Unit& u, int wr, int wc, int fr, int fq) const {
        const int row0 = u.pm * 256 + wr * 64 + fr;
#pragma unroll
        for (int ai = 0; ai < 2; ++ai)
#pragma unroll
            for (int m = 0; m < 4; ++m) {
                const int row = row0 + ai * 128 + m * 16;
#pragma unroll
                for (int bj = 0; bj < 2; ++bj)
#pragma unroll
                    for (int n = 0; n < 2; ++n) {
                        const int col = u.pn * 256 + bj * 128 + wc * 32 + n * 16 + 4 * fq; const f32x4 v = acc[ai][bj][m][n];
                        if (u.pn < 8) { u32x2 w; w.x = cvt_pk_bf16(v[0], v[1]); w.y = cvt_pk_bf16(v[2], v[3]); *(u32x2*)(mk + (size_t)row * 2048 + col) = w; }
                        else { const int cv = col - 2048, h = cv >> 9, dv = cv & 511, b = row >> 8, j = row & 255;
                            bf16_t* p = mvt + ((size_t)(b * 4 + h) * 512 + dv) * 256 + j;
                            const unsigned w0 = cvt_pk_bf16(v[0], v[1]), w1 = cvt_pk_bf16(v[2], v[3]);
                            p[0] = (bf16_t)(w0 & 0xffff); p[256] = (bf16_t)(w0 >> 16); p[512] = (bf16_t)(w1 & 0xffff); p[768] = (bf16_t)(w1 >> 16); }
                    }
            }
    }
};
template <int NS> __device__ __forceinline__ float slot_sum(const float* p) {
    float s = 0.f;
#pragma unroll
    for (int i = 0; i < NS / 4; ++i) { const f32x4 v = ((const f32x4*)p)[i]; s += (v[0] + v[1]) + (v[2] + v[3]); }
    return s;
}
struct EpiUQ {
    static constexpr bool PERM = true;
    const float* ssq; const f32x2* cs; bf16_t* q;
    __device__ __forceinline__ void operator()(AccRef acc, const Unit& u, int wr, int wc, int fr, int fq) const {
        const int row0 = u.pm * 256 + wr * 64 + fr;
#pragma unroll
        for (int ai = 0; ai < 2; ++ai) {
            float scv[4];
#pragma unroll
            for (int q = 0; q < 4; ++q) scv[q] = __builtin_amdgcn_rsqf(slot_sum<16>(ssq + (size_t)(row0 + ai * 128 + q * 16) * 16) * (1.f / 1024.f) + EPS) * C_MLA;
#pragma unroll
            for (int m = 0; m < 4; ++m) {
                const int row = row0 + ai * 128 + m * 16; const float sc = scv[m];
#pragma unroll
                for (int bj = 0; bj < 2; ++bj) {
                    const int col = u.pn * 256 + bj * 128 + wc * 32 + 8 * fq; const int d = col % 192;
                    f32x4 v0 = acc[ai][bj][m][0] * sc, v1 = acc[ai][bj][m][1] * sc;
                    if (d >= 128) {
                        const f32x2* c = cs + (size_t)row * 32 + ((d - 128) >> 1);
                        const f32x2 c0 = c[0], c1 = c[1], c2 = c[2], c3 = c[3];
                        f32x4 o0, o1;
                        o0[0] = v0[0] * c0.x - v0[1] * c0.y; o0[1] = v0[0] * c0.y + v0[1] * c0.x;
                        o0[2] = v0[2] * c1.x - v0[3] * c1.y; o0[3] = v0[2] * c1.y + v0[3] * c1.x;
                        o1[0] = v1[0] * c2.x - v1[1] * c2.y; o1[1] = v1[0] * c2.y + v1[1] * c2.x;
                        o1[2] = v1[2] * c3.x - v1[3] * c3.y; o1[3] = v1[2] * c3.y + v1[3] * c3.x;
                        v0 = o0; v1 = o1;
                    }
                    store_bf16x8(q + (size_t)row * 3072 + col, v0, v1);
                }
            }
        }
    }
};
struct EpiUKV {
    static constexpr bool PERM = true;
    const float* ssq; bf16_t* kn; bf16_t* vv;
    __device__ __forceinline__ void operator()(AccRef acc, const Unit& u, int wr, int wc, int fr, int fq) const {
        const int row0 = u.pm * 256 + wr * 64 + fr, cl = u.pn * 128 + wc * 32 + 8 * fq;
        float scv[8];
#pragma unroll
        for (int q = 0; q < 8; ++q) scv[q] = __builtin_amdgcn_rsqf(slot_sum<8>(ssq + (size_t)(row0 + (q >> 2) * 128 + (q & 3) * 16) * 8) * (1.f / 512.f) + EPS);
#pragma unroll
        for (int ai = 0; ai < 2; ++ai)
#pragma unroll
            for (int m = 0; m < 4; ++m) {
                const int row = row0 + ai * 128 + m * 16; const float sc = scv[ai * 4 + m];
                store_bf16x8(kn + (size_t)row * 3072 + u.pn * 192 + wc * 32 + 8 * fq, acc[ai][0][m][0] * sc, acc[ai][0][m][1] * sc);
                store_bf16x8(vv + (size_t)row * 2048 + cl, acc[ai][1][m][0] * sc, acc[ai][1][m][1] * sc);
            }
    }
};
struct EpiMemS {
    static constexpr bool PERM = false;
    float* s;
    __device__ __forceinline__ void operator()(AccRef acc, const Unit& u, int wr, int wc, int fr, int fq) const {
        const int b = u.z >> 2, h = u.z & 3, row0 = b * SEQ + u.pm * 256 + wr * 64 + fr;
#pragma unroll
        for (int ai = 0; ai < 2; ++ai)
#pragma unroll
            for (int m = 0; m < 4; ++m) { float* rowp = s + ((size_t)(row0 + ai * 128 + m * 16) * 4 + h) * 256 + wc * 32 + 4 * fq;
#pragma unroll
                for (int bj = 0; bj < 2; ++bj)
#pragma unroll
                    for (int n = 0; n < 2; ++n) *(f32x4*)(rowp + bj * 128 + n * 16) = acc[ai][bj][m][n]; }
    }
};
struct EpiMemPV {
    static constexpr bool PERM = true;
    unsigned char* y;
    __device__ __forceinline__ void operator()(AccRef acc, const Unit& u, int wr, int wc, int fr, int fq) const {
        const int b = u.z >> 2, h = u.z & 3, row0 = b * SEQ + u.pm * 256 + wr * 64 + fr, cl = h * 512 + u.pn * 256 + wc * 32 + 8 * fq;
#pragma unroll
        for (int ai = 0; ai < 2; ++ai)
#pragma unroll
            for (int m = 0; m < 4; ++m) { unsigned char* rowp = y + (size_t)(row0 + ai * 128 + m * 16) * 2048 + cl;
#pragma unroll
                for (int bj = 0; bj < 2; ++bj) { const f32x4 v0 = acc[ai][bj][m][0] * YC_SC, v1 = acc[ai][bj][m][1] * YC_SC;
                    int w0 = __builtin_amdgcn_cvt_pk_fp8_f32(v0[0], v0[1], 0, false); w0 = __builtin_amdgcn_cvt_pk_fp8_f32(v0[2], v0[3], w0, true);
                    int w1 = __builtin_amdgcn_cvt_pk_fp8_f32(v1[0], v1[1], 0, false); w1 = __builtin_amdgcn_cvt_pk_fp8_f32(v1[2], v1[3], w1, true);
                    *(u32x2*)(rowp + bj * 128) = (u32x2){(unsigned)w0, (unsigned)w1}; } }
    }
};
struct EpiMerge {
    static constexpr bool PERM = true;
    const bf16_t* gates; bf16_t* merged; unsigned char* mg8;
    __device__ __forceinline__ void operator()(AccRef acc, const Unit& u, int wr, int wc, int fr, int fq) const {
        const int row0 = u.pm * 256 + wr * 64 + fr, cl = u.pn * 256 + wc * 32 + 8 * fq;
        const float bsc = (u.z == 0 ? 1.f : (u.z == 1 ? 1.f / YB_SC : 1.f / YC_SC)) * (1.f / WBR_SC);
        const bf16_t* gtile = gates + ((size_t)(u.pm * 48 + u.z * 16 + u.pn) << 16); bf16_t* mtile = merged + ((size_t)(u.pm * 16 + u.pn) << 16);
        int lidx = ((wr * 4 + wc) * 16) * 64 + fq * 16 + fr;
        asm volatile("" : "+v"(lidx));
#pragma unroll
        for (int ai = 0; ai < 2; ++ai) {
            u32x4 gw[8], pw[8];
#pragma unroll
            for (int q = 0; q < 8; ++q) { const int row = row0 + ai * 128 + (q >> 1) * 16, bj = q & 1;
                const int pos = (lidx + ((ai * 4 + (q >> 1)) * 2 + bj) * 64) * 8; (void)row;
                gw[q] = *(const u32x4*)(gtile + pos);
                pw[q] = u.z > 0 ? *(const u32x4*)(mtile + pos) : (u32x4){0u, 0u, 0u, 0u}; }
#pragma unroll
            for (int q = 0; q < 8; ++q) { const int m = q >> 1, bj = q & 1, row = row0 + ai * 128 + m * 16;
                f32x4 v0 = acc[ai][bj][m][0] * bsc, v1 = acc[ai][bj][m][1] * bsc;
                v0[0] = fmaf(v0[0], bf_lo(gw[q].x), bf_lo(pw[q].x)); v0[1] = fmaf(v0[1], bf_hi(gw[q].x), bf_hi(pw[q].x)); v0[2] = fmaf(v0[2], bf_lo(gw[q].y), bf_lo(pw[q].y)); v0[3] = fmaf(v0[3], bf_hi(gw[q].y), bf_hi(pw[q].y));
                v1[0] = fmaf(v1[0], bf_lo(gw[q].z), bf_lo(pw[q].z)); v1[1] = fmaf(v1[1], bf_hi(gw[q].z), bf_hi(pw[q].z)); v1[2] = fmaf(v1[2], bf_lo(gw[q].w), bf_lo(pw[q].w)); v1[3] = fmaf(v1[3], bf_hi(gw[q].w), bf_hi(pw[q].w));
                if (u.z < 2) store_bf16x8(mtile + (lidx + ((ai * 4 + m) * 2 + bj) * 64) * 8, v0, v1);
                else { int w0 = __builtin_amdgcn_cvt_pk_fp8_f32(v0[0] * MG_SC, v0[1] * MG_SC, 0, false); w0 = __builtin_amdgcn_cvt_pk_fp8_f32(v0[2] * MG_SC, v0[3] * MG_SC, w0, true);
                    int w1 = __builtin_amdgcn_cvt_pk_fp8_f32(v1[0] * MG_SC, v1[1] * MG_SC, 0, false); w1 = __builtin_amdgcn_cvt_pk_fp8_f32(v1[2] * MG_SC, v1[3] * MG_SC, w1, true);
                    *(u32x2*)(mg8 + (size_t)row * 4096 + cl + bj * 128) = (u32x2){(unsigned)w0, (unsigned)w1}; } }
        }
    }
};
struct EpiOut {
    static constexpr bool PERM = true;
    const float* x; float* h1; bf16_t* h1b; float* ssq; float osc;
    __device__ __forceinline__ void operator()(AccRef acc, const Unit& u, int wr, int wc, int fr, int fq) const {
        const int row0 = u.pm * 256 + wr * 64 + fr, cl = u.pn * 256 + wc * 32 + 8 * fq;
#pragma unroll
        for (int ai = 0; ai < 2; ++ai) {
            f32x4 xv[16];
#pragma unroll
            for (int q = 0; q < 16; ++q) xv[q] = *(const f32x4*)(x + (size_t)(row0 + ai * 128 + (q >> 2) * 16) * D + cl + ((q >> 1) & 1) * 128 + (q & 1) * 4);
#pragma unroll
            for (int m = 0; m < 4; ++m) {
                const int row = row0 + ai * 128 + m * 16; float s2 = 0.f;
#pragma unroll
                for (int bj = 0; bj < 2; ++bj) {
                    const f32x4 v0 = acc[ai][bj][m][0] * osc + xv[m * 4 + bj * 2], v1 = acc[ai][bj][m][1] * osc + xv[m * 4 + bj * 2 + 1];
                    store_bf16x8(h1b + (size_t)row * D + cl + bj * 128, v0, v1);
                    s2 += ((v0[0] * v0[0] + v0[1] * v0[1]) + (v0[2] * v0[2] + v0[3] * v0[3])) + ((v1[0] * v1[0] + v1[1] * v1[1]) + (v1[2] * v1[2] + v1[3] * v1[3]));
                }
                s2 += __shfl_xor(s2, 16); s2 += __shfl_xor(s2, 32); if (fq == 0) ssq[(size_t)row * 64 + u.pn * 4 + wc] = s2;
            }
        }
    }
};
struct EpiPQ {
    static constexpr bool PERM = true;
    const float* ssq; bf16_t* pq;
    __device__ __forceinline__ void operator()(AccRef acc, const Unit& u, int wr, int wc, int fr, int fq) const {
        const int row0 = u.pm * 256 + wr * 64 + fr, cl = u.pn * 256 + wc * 32 + 8 * fq;
        float scv[8];
#pragma unroll
        for (int q = 0; q < 8; ++q) scv[q] = __builtin_amdgcn_rsqf(slot_sum<64>(ssq + (size_t)(row0 + (q >> 2) * 128 + (q & 3) * 16) * 64) * (1.f / 4096.f) + EPS);
#pragma unroll
        for (int ai = 0; ai < 2; ++ai)
#pragma unroll
            for (int m = 0; m < 4; ++m) {
                const int row = row0 + ai * 128 + m * 16;
                const float sc = scv[ai * 4 + m];
#pragma unroll
                for (int bj = 0; bj < 2; ++bj) store_bf16x8(pq + (size_t)row * 2048 + cl + bj * 128, acc[ai][bj][m][0] * sc, acc[ai][bj][m][1] * sc);
            }
    }
};

#define XB_TMO      128
#define XB_XCNT(j)  (256  + 64 * (j))
#define XB_XSUB(j)  (1280 + 64 * (j))
#define XB_XGEN(j)  (2304 + 64 * (j))
#define XB_TOP      3328
#define XB_TOPGEN   3392
#define XCD_BAR_WORDS 3456
#define XB_SPIN_CAP (1u << 20)
__device__ __forceinline__ unsigned xb_ld(unsigned* p)              { return __hip_atomic_load(p, __ATOMIC_RELAXED, __HIP_MEMORY_SCOPE_AGENT); }
__device__ __forceinline__ unsigned xb_add(unsigned* p, unsigned v) { return __hip_atomic_fetch_add(p, v, __ATOMIC_RELAXED, __HIP_MEMORY_SCOPE_AGENT); }
__device__ __forceinline__ unsigned xb_xcc_id() { return (unsigned)__builtin_amdgcn_s_getreg((3 << 11) | 20) & 0xFu; }
#define XB_SPIN(cond, bar) do { unsigned _sp = 0; while (cond) { __builtin_amdgcn_s_sleep(1); \
    if ((++_sp & 255u) == 0u) { if (xb_ld(&(bar)[XB_TMO])) break; if (_sp > XB_SPIN_CAP) { atomicAdd(&(bar)[XB_TMO], 1u); break; } } } } while (0)
struct XcdBarrier { unsigned* bar; unsigned x; volatile LAS unsigned* st; };
__device__ __forceinline__ XcdBarrier xcd_barrier_post(unsigned* bar, volatile LAS unsigned* st) {
    XcdBarrier b; b.bar = bar; b.x = xb_xcc_id(); b.st = st;
    if (threadIdx.x == 0) (void)xb_add(&bar[XB_XCNT(b.x)], 1u);
    return b;
}
__device__ __forceinline__ void xcd_barrier_complete(unsigned* bar, unsigned x, unsigned& nloc, unsigned& nx) {
    const unsigned G = gridDim.x * gridDim.y * gridDim.z;
    unsigned sum, cnt, mine, sp = 0u;
    for (;;) {
        sum = 0u; cnt = 0u; mine = 0u;
#pragma unroll
        for (unsigned j = 0; j < 16; ++j) { const unsigned c = xb_ld(&bar[XB_XCNT(j)]); sum += c; cnt += (c > 0u) ? 1u : 0u; mine = (j == x) ? c : mine; }
        if (sum == G) break;
        __builtin_amdgcn_s_sleep(1);
        if ((++sp & 255u) == 0u) { if (xb_ld(&bar[XB_TMO])) break; if (sp > XB_SPIN_CAP) { atomicAdd(&bar[XB_TMO], 1u); break; } }
    }
    nloc = mine > 0u ? mine : 1u; nx = cnt > 0u ? cnt : 1u;
}
__device__ __forceinline__ void xcd_barrier(const XcdBarrier& b) {
    asm volatile("s_waitcnt vmcnt(0)" ::: "memory");
    __syncthreads();
    if (threadIdx.x == 0) {
        unsigned* bar = b.bar;
        __builtin_amdgcn_s_waitcnt(0);
        unsigned nloc = b.st[0], nx = b.st[1];
        if (nloc == 0u) { xcd_barrier_complete(bar, b.x, nloc, nx); b.st[0] = nloc; b.st[1] = nx; }
        const unsigned old = xb_add(&bar[XB_XSUB(b.x)], 1u);
        const unsigned gen = old / nloc;
        if (old + 1u == (gen + 1u) * nloc) {
            __builtin_amdgcn_fence(__ATOMIC_RELEASE, "agent");
            asm volatile("s_waitcnt vmcnt(0)" ::: "memory");
            const unsigned og = xb_add(&bar[XB_TOP], 1u);
            const unsigned tg = og / nx;
            if (og + 1u == (tg + 1u) * nx) xb_add(&bar[XB_TOPGEN], 1u);
            else XB_SPIN(xb_ld(&bar[XB_TOPGEN]) == tg, bar);
            __builtin_amdgcn_fence(__ATOMIC_ACQUIRE, "agent");
            xb_add(&bar[XB_XGEN(b.x)], 1u);
            asm volatile("s_waitcnt vmcnt(0)" ::: "memory");
        } else {
            XB_SPIN(xb_ld(&bar[XB_XGEN(b.x)]) == gen, bar);
            __builtin_amdgcn_fence(__ATOMIC_ACQUIRE, "agent");
            asm volatile("s_waitcnt vmcnt(0)" ::: "memory");
        }
    }
    __syncthreads();
}

template <class Map, bool F8 = false>
__device__ __forceinline__ void tr_item(const float* W, int K, int Nsrc, bf16_t* WT, const float* gain, LAS float* scr, int item, int nblk, int lane, Map map, float osc = 1.f) {
    const int kb = item / nblk, nb = item % nblk, k0 = 64 * kb, j0 = 32 * nb;
    if (Map::CONTIG) {
        const int sc0 = map(j0);
        f32x4 v[8];
#pragma unroll
        for (int q = 0; q < 8; ++q) { const int idx = q * 64 + lane, row = idx >> 3, c4 = idx & 7;
            v[q] = sc0 >= 0 ? *(const f32x4*)(W + (size_t)(k0 + row) * Nsrc + sc0 + c4 * 4) : (f32x4){0.f, 0.f, 0.f, 0.f}; }
#pragma unroll
        for (int q = 0; q < 8; ++q) { const int idx = q * 64 + lane, row = idx >> 3, c4 = idx & 7; f32x4 w = v[q]; if (gain) w = w * gain[k0 + row];
            LAS float* d = scr + row * 33 + c4 * 4; d[0] = w[0]; d[1] = w[1]; d[2] = w[2]; d[3] = w[3]; }
    } else {
        const int sc = map(j0 + (lane & 31));
#pragma unroll 8
        for (int i = 0; i < 32; ++i) { const int kk = 2 * i + (lane >> 5); float v = sc >= 0 ? W[(size_t)(k0 + kk) * Nsrc + sc] : 0.f; if (gain) v *= gain[k0 + kk]; scr[kk * 33 + (lane & 31)] = v; }
    }
    LDS_WAIT(); asm volatile("" ::: "memory");
    const int c = lane & 7;
#pragma unroll
    for (int j = 0; j < 4; ++j) { const int n = (lane >> 3) + 8 * j; const LAS float* s = scr + (8 * c) * 33 + n;
        if (F8) { int w0 = __builtin_amdgcn_cvt_pk_fp8_f32(s[0 * 33] * osc, s[1 * 33] * osc, 0, false); w0 = __builtin_amdgcn_cvt_pk_fp8_f32(s[2 * 33] * osc, s[3 * 33] * osc, w0, true);
            int w1 = __builtin_amdgcn_cvt_pk_fp8_f32(s[4 * 33] * osc, s[5 * 33] * osc, 0, false); w1 = __builtin_amdgcn_cvt_pk_fp8_f32(s[6 * 33] * osc, s[7 * 33] * osc, w1, true);
            *(u32x2*)((unsigned char*)WT + (size_t)(j0 + n) * K + k0 + 8 * c) = (u32x2){(unsigned)w0, (unsigned)w1}; }
        else { u32x4 o; o.x = cvt_pk_bf16(s[0 * 33], s[1 * 33]); o.y = cvt_pk_bf16(s[2 * 33], s[3 * 33]); o.z = cvt_pk_bf16(s[4 * 33], s[5 * 33]); o.w = cvt_pk_bf16(s[6 * 33], s[7 * 33]);
            *(u32x4*)(WT + (size_t)(j0 + n) * K + k0 + 8 * c) = o; } }
    LDS_WAIT(); asm volatile("" ::: "memory");
}
struct MapId { static constexpr bool CONTIG = true; __device__ __forceinline__ int operator()(int j) const { return j; } };
struct MapWin { static constexpr bool CONTIG = true; __device__ __forceinline__ int operator()(int j) const { return j < 7744 ? j : (j < 7936 ? -1 : j - 192); } };
struct MapGate { static constexpr bool CONTIG = true; __device__ __forceinline__ int operator()(int j) const { return 7744 + j; } };
struct MapUq { static constexpr bool CONTIG = false; __device__ __forceinline__ int operator()(int j) const { const int h = j / 192, d = j % 192; if (d < 128) return j; const int e = d - 128; return h * 192 + 128 + (e & 1) * 32 + (e >> 1); } };

__device__ __forceinline__ float row_to_bf16(const float* xrow, bf16_t* orow, const float* gain, int lane, unsigned* o8 = nullptr) {
    const f32x4* xr = (const f32x4*)xrow + lane;
    f32x4 v[16]; float s = 0.f;
#pragma unroll
    for (int j = 0; j < 16; ++j) { v[j] = xr[64 * j]; s += (v[j][0] * v[j][0] + v[j][1] * v[j][1]) + (v[j][2] * v[j][2] + v[j][3] * v[j][3]); }
    const float rs = __builtin_amdgcn_rsqf(wave_sum(s) * (1.f / 4096.f) + EPS);
    u32x2* o8b = (u32x2*)orow + lane;
#pragma unroll
    for (int j = 0; j < 16; ++j) {
        f32x4 w = v[j];
        if (gain) { const f32x4 g = ((const f32x4*)gain)[64 * j + lane]; w = w * rs * g; }
        u32x2 p; p.x = cvt_pk_bf16(w[0], w[1]); p.y = cvt_pk_bf16(w[2], w[3]); o8b[64 * j] = p;
        if (o8) { int q = __builtin_amdgcn_cvt_pk_fp8_f32(w[0], w[1], 0, false); q = __builtin_amdgcn_cvt_pk_fp8_f32(w[2], w[3], q, true); o8[64 * j + lane] = (unsigned)q; } }
    return rs;
}
__device__ __forceinline__ f32x2 cossin(float xf) {
    const double x = (double)xf;
    const double k = __builtin_rint(x * 0.63661977236758134308);
    double r = __builtin_fma(-k, 1.57079632679489655800e+00, x); r = __builtin_fma(-k, 6.12323399573676603587e-17, r);
    const double r2 = r * r;
    double s = -2.5052108385441718775e-08; s = s * r2 + 2.7557319223985890653e-06; s = s * r2 - 1.9841269841269841253e-04; s = s * r2 + 8.3333333333333332177e-03; s = s * r2 - 1.6666666666666665741e-01; s = r + r * r2 * s;
    double c = -2.7557319223985888e-07; c = c * r2 + 2.4801587301587302e-05; c = c * r2 - 1.3888888888888889e-03; c = c * r2 + 4.1666666666666664e-02; c = c * r2 - 0.5; c = 1.0 + r2 * c;
    const int q = ((int)k) & 3;
    const double cc = (q == 0) ? c : (q == 1) ? -s : (q == 2) ? -c : s;
    const double ss = (q == 0) ? s : (q == 1) ? c : (q == 2) ? -s : -c;
    return (f32x2){(float)cc, (float)ss};
}

struct AttnArgs { const bf16_t* q; const bf16_t* k; const bf16_t* v; unsigned char* y; float ysc; };
template <int MODE>
__device__ __forceinline__ void attn_phase(LAS unsigned char* lds, const AttnArgs& A, int G, int c) {
    constexpr int DQK = MODE == 0 ? 192 : 128, NKS = DQK / 16, KP = DQK * 2 + 16, VP = 320, QP = MODE == 0 ? 3072 : 2048;
    constexpr int KCH = DQK / 8;
    constexpr int KB0 = 0, KBS = 64 * KP, VB0 = 2 * KBS, VBS = 64 * VP, FLAG0 = VB0 + 2 * VBS;
    const int tid = threadIdx.x, wid = __builtin_amdgcn_readfirstlane(tid >> 6), lane = tid & 63, hi = lane >> 5, li = lane & 15;
    LAS unsigned* flags = (LAS unsigned*)(lds + FLAG0);
    const int xk = c & 7, xa = c >> 3;
    for (int it = 0; it < 2 * ((512 + G - 1) / G); ++it) {
        const int round = it >> 1, half = it & 1;
        int bh, qb;
        if (G == 256) { bh = 2 * xk + (xa >> 4) + 16 * round; qb = xa & 15; if (round >= 2) break; }
        else { const int p = c + round * G; if (p >= 512) break; bh = p >> 4; qb = p & 15; }
        if (half) qb = 31 - qb;
        const int b = bh >> 4, h = bh & 15, t0 = qb * 256, jmax = 4 * qb + 3, ntile = jmax + 1;
        const size_t rowbase = (size_t)b * SEQ;
        const int wrow0 = t0 + 32 * wid;
        const int tq = wrow0 + (lane & 31);
        bf16x8 qf[NKS];
        { const bf16_t* qp = A.q + (rowbase + tq) * QP + h * DQK + 8 * hi;
#pragma unroll
          for (int ks = 0; ks < NKS; ++ks) qf[ks] = *(const bf16x8*)(qp + 16 * ks); }
        f32x16 o[4];
#pragma unroll
        for (int d = 0; d < 4; ++d)
#pragma unroll
            for (int r = 0; r < 16; ++r) o[d][r] = 0.f;
        float m_run = -1e30f, l_run = 0.f, r_run = 0.f;
        auto issue_dma = [&](int j, int buf) {
            constexpr int KCPR = KCH + 1, KLOADS = KCPR, VLOADS = 20, KPB = MODE == 0 ? 6144 : 4096;
            const char* kbase = (const char*)A.k + ((rowbase + (size_t)64 * j) * KPB + (size_t)h * (DQK * 2));
            const char* vbase = (const char*)A.v + ((rowbase + (size_t)64 * j) * 4096 + (size_t)h * 256);
#pragma unroll
            for (int i = 0; i < (KLOADS + 7) / 8; ++i) { const int wl = wid + 8 * i;
                if (wl < KLOADS) { const int gch = wl * 64 + lane, row = gch / KCPR; int cc = gch % KCPR; if (cc == KCH) cc = 0;
                    __builtin_amdgcn_global_load_lds((const unsigned*)(kbase + (unsigned)(row * KPB + cc * 16)), (LAS unsigned*)(lds + KB0 + buf * KBS + wl * 1024), 16, 0, 0); } }
#pragma unroll
            for (int i = 0; i < (VLOADS + 7) / 8; ++i) { const int wl = wid + 8 * i;
                if (wl < VLOADS) { const int gch = wl * 64 + lane, row = gch / 20, cc = (gch % 20) & 15;
                    __builtin_amdgcn_global_load_lds((const unsigned*)(vbase + (unsigned)(row * 4096 + cc * 16)), (LAS unsigned*)(lds + VB0 + buf * VBS + wl * 1024), 16, 0, 0); } }
        };
        __syncthreads();
        issue_dma(MODE == 0 ? 0 : jmax, 0);
        VM_WAIT();
        __syncthreads();
        bool wdone = false;
        for (int i = 0; i < ntile; ++i) {
            const int j = MODE == 0 ? i : jmax - i, buf = i & 1;
            const bool more = i + 1 < ntile;
            if (more) issue_dma(MODE == 0 ? j + 1 : j - 1, buf ^ 1);
            const int k0 = 64 * j;
            bool active;
            if (MODE == 0) active = k0 <= wrow0 + 31; else active = (k0 < wrow0 + 31) && !wdone;
            if (active) {
                const LAS unsigned char* kb = lds + KB0 + buf * KBS + (lane & 31) * KP + hi * 16;
                const LAS unsigned char* vb = lds + VB0 + buf * VBS + (4 * hi + (li >> 2)) * VP + (16 * ((lane >> 4) & 1) + 4 * (li & 3)) * 2;
                const int dq0 = tq - k0 - 4 * hi;
#pragma unroll
                for (int kk = 0; kk < 2; ++kk) {
                    const int kt = MODE == 0 ? kk : 1 - kk;
                    const int dq = dq0 - 32 * kt;
                    if (MODE == 0 ? (k0 + 32 * kt > wrow0 + 31) : (k0 + 32 * kt >= wrow0 + 31)) continue;
                    f32x16 p;
#pragma unroll
                    for (int r = 0; r < 16; ++r) p[r] = 0.f;
#pragma unroll
                    for (int ks = 0; ks < NKS; ++ks) {
                        const bf16x8 a0 = *(const LAS bf16x8*)(kb + kt * 32 * KP + ks * 32);
                        p = __builtin_amdgcn_mfma_f32_32x32x16_bf16(a0, qf[ks], p, 0, 0, 0);
                    }
                    if (MODE == 0) {
                        if (k0 + 32 * kt + 31 > wrow0) {
#pragma unroll
                            for (int r = 0; r < 16; ++r) { const int cr = (r & 3) + 8 * (r >> 2); if (cr > dq) p[r] = -__builtin_inff(); }
                        }
                        float pmax = p[0];
#pragma unroll
                        for (int r = 1; r < 16; ++r) pmax = fmaxf(pmax, p[r]);
                        pmax = xor32_max(pmax);
                        const float mn = pmax > m_run + 8.f ? pmax : m_run, alpha = fexp2(m_run - mn); m_run = mn;
                        float ps = 0.f;
#pragma unroll
                        for (int r = 0; r < 16; ++r) { p[r] = fexp2(p[r] - mn); ps += p[r]; }
                        ps = xor32_sum(ps);
                        l_run = l_run * alpha + ps;
                        if (!__all(alpha == 1.f)) {
#pragma unroll
                            for (int d = 0; d < 4; ++d)
#pragma unroll
                                for (int r = 0; r < 16; ++r) o[d][r] *= alpha;
                        }
                    } else {
                        float lk[16];
#pragma unroll
                        for (int r = 0; r < 16; ++r) { const int cr = (r & 3) + 8 * (r >> 2); const float z = p[r];
                            const float sp = fmaxf(z, 0.f) + flog2(1.f + fexp2(-fabsf(z)));
                            lk[r] = (cr < dq) ? -sp : 0.f; }
                        float sg[4], pg[4];
#pragma unroll
                        for (int g = 0; g < 4; ++g) { sg[g] = (lk[4 * g] + lk[4 * g + 1]) + (lk[4 * g + 2] + lk[4 * g + 3]); pg[g] = xor32_partner(sg[g], hi); }
                        const float t3 = sg[3] + pg[3], t2 = sg[2] + pg[2], t1 = sg[1] + pg[1], t0s = sg[0] + pg[0];
                        float ub[4]; ub[3] = 0.f; ub[2] = t3; ub[1] = t3 + t2; ub[0] = t3 + t2 + t1;
#pragma unroll
                        for (int g = 0; g < 4; ++g) {
                            float aft = r_run + ub[g] + (hi ? 0.f : pg[g]);
#pragma unroll
                            for (int e = 3; e >= 0; --e) { const int r = 4 * g + e; const int cr = (r & 3) + 8 * (r >> 2);
                                const float w = (cr < dq) ? fexp2(p[r] + lk[r] + aft) : 0.f; aft += lk[r]; p[r] = w; }
                        }
                        r_run += (t3 + t2) + (t1 + t0s);
                    }
#pragma unroll
                    for (int s = 0; s < 2; ++s) {
                        u32x4 w0;
                        w0.x = cvt_pk_bf16(p[8 * s + 0], p[8 * s + 1]); w0.y = cvt_pk_bf16(p[8 * s + 2], p[8 * s + 3]); w0.z = cvt_pk_bf16(p[8 * s + 4], p[8 * s + 5]); w0.w = cvt_pk_bf16(p[8 * s + 6], p[8 * s + 7]);
                        const bf16x8 pf = __builtin_bit_cast(bf16x8, w0);
#pragma unroll
                        for (int d = 0; d < 4; ++d) {
                            const s16x4 lo = __builtin_amdgcn_ds_read_tr16_b64_v4i16((LAS s16x4*)(vb + (32 * kt + 16 * s) * VP + d * 64));
                            const s16x4 hh = __builtin_amdgcn_ds_read_tr16_b64_v4i16((LAS s16x4*)(vb + (32 * kt + 16 * s + 8) * VP + d * 64));
                            const bf16x8 af = {lo[0], lo[1], lo[2], lo[3], hh[0], hh[1], hh[2], hh[3]};
                            o[d] = __builtin_amdgcn_mfma_f32_32x32x16_bf16(af, pf, o[d], 0, 0, 0);
                        }
                    }
                }
            }
            if (MODE == 1) {
                wdone = wdone || (bool)__all(r_run < SB_DONE);
                if (lane == 0) flags[(i & 1) * 8 + wid] = wdone ? 1u : 0u;
            }
            VM_WAIT();
            __syncthreads();
            if (MODE == 1) {
                unsigned alld = 1u;
#pragma unroll
                for (int w = 0; w < 8; ++w) alld &= flags[(i & 1) * 8 + w];
                if (alld) break;
            }
        }
        const float inv = (MODE == 0 ? frcp(l_run) : 1.f) * A.ysc;
        unsigned char* yp = A.y + (rowbase + tq) * 2048 + h * 128 + 4 * hi;
#pragma unroll
        for (int d = 0; d < 4; ++d)
#pragma unroll
            for (int g = 0; g < 4; ++g) { int w = __builtin_amdgcn_cvt_pk_fp8_f32(o[d][4 * g] * inv, o[d][4 * g + 1] * inv, 0, false); w = __builtin_amdgcn_cvt_pk_fp8_f32(o[d][4 * g + 2] * inv, o[d][4 * g + 3] * inv, w, true);
                *(unsigned*)(yp + 32 * d + 8 * g) = (unsigned)w; }
    }
}

__device__ __forceinline__ const float* karg_in(int i) { const char* ka = (const char*)__builtin_amdgcn_kernarg_segment_ptr(); asm volatile("" : "+s"(ka)); return *(const float* const*)(ka + 8 * i); }
struct Args { const float* in[19]; const int* pos; float* out; unsigned char* ws; int ph_lo, ph_hi, li, bar_on; };

__global__ void __launch_bounds__(NTHREADS, 2) hybrid_fwd(Args args) {
    extern __shared__ __attribute__((aligned(16))) unsigned char lds_raw[];
    LAS unsigned char* lds = (LAS unsigned char*)lds_raw;
    volatile LAS unsigned* MISC = (volatile LAS unsigned*)(lds + MISC_OFF);
    const int tid = threadIdx.x, lane = tid & 63, wave = __builtin_amdgcn_readfirstlane(tid >> 6);
    const int G = gridDim.x, c = blockIdx.x;
    unsigned char* ws = args.ws;
    if (tid < 16) MISC[tid] = 0u;
    __syncthreads();
    XcdBarrier bar; bar.bar = (unsigned*)(ws + WS_CTL) + args.li * XCD_BAR_WORDS; bar.x = 0; bar.st = nullptr;
    const bool bar_on = args.bar_on != 0;
    if (bar_on) bar = xcd_barrier_post((unsigned*)(ws + WS_CTL) + args.li * XCD_BAR_WORDS, MISC + 8);
#define GRID_BAR() do { if (bar_on) xcd_barrier(bar); } while (0)
    const int lo = args.ph_lo, hi_ph = args.ph_hi;
#ifndef ONLY_PHASE
#define ONLY_PHASE -1
#endif
#define IN(k) ((ONLY_PHASE < 0 || ONLY_PHASE == (k)) && lo <= (k) && (k) < hi_ph)

#define I_x (karg_in(0))
#define I_mem (karg_in(1))
#define I_g_mix (karg_in(3))
#define I_w_in (karg_in(4))
#define I_g_q (karg_in(5))
#define I_w_uq (karg_in(6))
#define I_g_kv (karg_in(7))
#define I_w_ukv (karg_in(8))
#define I_g_mem (karg_in(9))
#define I_w_mkv (karg_in(10))
#define I_w_br (karg_in(11))
#define I_w_out (karg_in(12))
#define I_g_ffn (karg_in(13))
#define I_w_pq (karg_in(14))
#define I_subk (karg_in(15))
#define I_u_tab (karg_in(16))
#define I_v_tab (karg_in(17))
#define I_g_fin (karg_in(18))
#define RS ((float*)(ws + WS_RS))
#define SSQ_DQ ((float*)(ws + WS_SSQ_DQ))
#define SSQ_DKV ((float*)(ws + WS_SSQ_DKV))
#define SSQ_H ((float*)(ws + WS_SSQ_H))
#define CS ((f32x2*)(ws + WS_CS))
#define MEMN ((bf16_t*)(ws + WS_MEMN))
#define MK ((bf16_t*)(ws + WS_MK))
#define MVT ((bf16_t*)(ws + WS_MVT))
#define SKB ((bf16_t*)(ws + WS_SKB))
#define WUQ ((bf16_t*)(ws + WS_WUQ))
#define WUKV ((bf16_t*)(ws + WS_WUKV))
#define WMKV ((bf16_t*)(ws + WS_WMKV))
#define WBR ((bf16_t*)(ws + WS_WBR))
#define WOUT ((bf16_t*)(ws + WS_WOUT))
#define WPQ ((bf16_t*)(ws + WS_WPQ))
#define YMLA ((bf16_t*)(ws + WS_YMLA))
#define XB ((bf16_t*)(ws + WS_XB))
#define WIN ((bf16_t*)(ws + WS_WIN))
#define QMLA ((bf16_t*)(ws + WS_QMLA))
#define KF ((bf16_t*)(ws + WS_KF))
#define VV ((bf16_t*)(ws + WS_VV))
#define SMEM ((float*)(ws + WS_SMEM))
#define H1B ((bf16_t*)(ws + WS_H1B))
#define ROUTE ((u32x2*)(ws + WS_ROUTE))
#define SBQ ((bf16_t*)(ws + WS_SBQ))
#define SBK ((bf16_t*)(ws + WS_SBK))
#define SBV ((bf16_t*)(ws + WS_SBV))
#define DQ ((bf16_t*)(ws + WS_DQ))
#define DKV ((bf16_t*)(ws + WS_DKV))
#define MEMQ ((bf16_t*)(ws + WS_MEMQ))
#define GATES ((bf16_t*)(ws + WS_GATES))
#define MERGED ((bf16_t*)(ws + WS_MERGED))
#define PQ ((bf16_t*)(ws + WS_PQ))
#define UTAB ((bf16_t*)(ws + WS_UTAB))
#define VTAB ((bf16_t*)(ws + WS_VTAB))
#define DEF_GIDX() int c_op = c; asm volatile("" : "+s"(c_op)); const int gw = c_op * NWAVES + wave, NGW = G * NWAVES, gt = c_op * NTHREADS + tid, NGT = G * NTHREADS; (void)gw; (void)NGW; (void)gt; (void)NGT

    if (IN(0)) {
        DEF_GIDX();
        LAS float* scr = (LAS float*)(lds + wave * 16384);
        constexpr int I_WIN = 64 * (NPROJ_BF / 32), I_WG8 = 64 * (NPROJ_F8 / 32), I_UQ = 16 * 96, I_UKV = 8 * 128, I_MKV = 64 * 128, I_BR = 32 * 128, I_OUT = 64 * 128, I_PQ = 64 * 64;
        constexpr int NITEMS = I_WIN + I_WG8 + I_UQ + I_UKV + I_MKV + 3 * I_BR + I_OUT + I_PQ;
        for (int it = gw; it < NITEMS; it += NGW) {
            int r = it;
            if (r < I_WIN) { tr_item(I_w_in, 4096, IN_COLS, WIN, I_g_mix, scr, r, NPROJ_BF / 32, lane, MapWin()); continue; } r -= I_WIN;
            if (r < I_WG8) { tr_item<MapGate, true>(I_w_in, 4096, IN_COLS, (bf16_t*)(ws + WS_WIN8), I_g_mix, scr, r, NPROJ_F8 / 32, lane, MapGate(), WG8_SC); continue; } r -= I_WG8;
            if (r < I_UQ) { tr_item(I_w_uq, 1024, 3072, WUQ, I_g_q, scr, r, 96, lane, MapUq()); continue; } r -= I_UQ;
            if (r < I_UKV) { tr_item(I_w_ukv, 512, 4096, WUKV, I_g_kv, scr, r, 128, lane, MapId()); continue; } r -= I_UKV;
            if (r < I_MKV) { tr_item(I_w_mkv, 4096, 4096, WMKV, nullptr, scr, r, 128, lane, MapId()); continue; } r -= I_MKV;
            if (r < 3 * I_BR) { const int z = r / I_BR; tr_item<MapId, true>(I_w_br + (size_t)z * 2048 * 4096, 2048, 4096, (bf16_t*)((unsigned char*)WBR + (size_t)z * 4096 * 2048), nullptr, scr, r % I_BR, 128, lane, MapId(), WBR_SC); continue; } r -= 3 * I_BR;
            if (r < I_OUT) { tr_item<MapId, true>(I_w_out, 4096, 4096, WOUT, nullptr, scr, r, 128, lane, MapId(), WOUT_SC); continue; } r -= I_OUT;
            tr_item(I_w_pq, 4096, 2048, WPQ, I_g_ffn, scr, r, 64, lane, MapId());
        }
        for (int m = gw; m < T; m += NGW) { const float rs = row_to_bf16(I_x + (size_t)m * D, XB + (size_t)m * D, nullptr, lane, (unsigned*)(ws + WS_XB8) + (size_t)m * (D / 4)); if (lane == 0) RS[m] = rs; }
        for (int m = gw; m < 512; m += NGW) (void)row_to_bf16(I_mem + (size_t)m * D, MEMN + (size_t)m * D, I_g_mem, lane);
        for (int i = gt; i < T * 32; i += NGT) { const int t = i >> 5, f = i & 31;
            const float freq = exp2f(-(float)f * (13.287712379549449f / 32.f));
            const float ang = (float)((const int*)karg_in(19))[t] * freq; CS[i] = cossin(ang); }
        for (int i = gt; i < 8 * 2 * 128 * 128 / 4; i += NGT) { const f32x4 v = ((const f32x4*)I_subk)[i]; u32x2 w; w.x = cvt_pk_bf16(v[0], v[1]); w.y = cvt_pk_bf16(v[2], v[3]); ((u32x2*)SKB)[i] = w; }
        GRID_BAR();
    }
    if (IN(1)) {
        { pg8::SchedB S; S.init(T, NPROJ_BF, 1, G, c, XB, WIN, D, D, 0, 0);
          EpiProj E{RS, SBQ, DQ, DKV, MEMQ, GATES, SSQ_DQ, SSQ_DKV, 0, 1.f};
          pg8::gemm_phase<EpiProj, pg8::SchedB>(lds, pg8::Gemm{D, D, D}, S, E); }
        { pg8::SchedB S; S.init(T, NPROJ_F8, 1, G, c, ws + WS_XB8, ws + WS_WIN8, D / 2, D / 2, 0, 0);
          EpiProj E{RS, SBQ, DQ, DKV, MEMQ, GATES, SSQ_DQ, SSQ_DKV, 31, 1.f / WG8_SC};
          pg8::gemm_phase_f8<EpiProj, pg8::SchedB>(lds, pg8::Gemm{D, D, D}, S, E); }
        { const int cm = G >= 64 ? (c >= G - 32 ? c - (G - 32) : c + 32) : c;
          pg8::SchedB S; S.init(512, 4096, 1, G, cm, MEMN, WMKV, D, D, 0, 0);
          EpiMemKV E{MK, MVT};
          pg8::gemm_phase<EpiMemKV, pg8::SchedB>(lds, pg8::Gemm{D, D, D}, S, E); }
        GRID_BAR();
    }
    if (IN(2)) {
        { pg8::SchedB S; S.init(T, 3072, 1, G, c, DQ, WUQ, 1024, 1024, 0, 0);
          EpiUQ E{SSQ_DQ, CS, QMLA};
          pg8::gemm_phase<EpiUQ, pg8::SchedB>(lds, pg8::Gemm{1024, 1024, 1024}, S, E); }
        { pg8::SchedB S; S.init(T, 4096, 1, G, c, DKV, WUKV, 768, 512, 0, 0);
          EpiUKV E{SSQ_DKV, KF, VV};
          pg8::gemm_phase<EpiUKV, pg8::SchedB>(lds, pg8::Gemm{512, 768, 512}, S, E); }
        { pg8::SchedB S; S.init(SEQ, 256, 8, G, c, MEMQ, MK, 2048, 2048, 0, 0);
          S.zA = 0; S.zB = 0;
          struct SchedMS : pg8::SchedB {
              __device__ __forceinline__ const char* pa(const Unit& u) const { return A + ((size_t)(u.z >> 2) * SEQ * 2048 + (size_t)(u.z & 3) * 512) * 2 + (size_t)u.pm * tA; }
              __device__ __forceinline__ const char* pb(const Unit& u) const { return B + ((size_t)(u.z >> 2) * 256 * 2048 + (size_t)(u.z & 3) * 512) * 2 + (size_t)u.pn * tB; }
          } S2; (pg8::SchedB&)S2 = S;
          EpiMemS E{SMEM};
          pg8::gemm_phase<EpiMemS, SchedMS>(lds, pg8::Gemm{512, 2048, 2048}, S2, E); }
        DEF_GIDX();
        for (int i = gt; i < T * 32; i += NGT) { const int t = i >> 5, f = i & 31;
            const float t1 = bf_lo((unsigned)DKV[(size_t)t * 768 + 512 + f]), t2 = bf_lo((unsigned)DKV[(size_t)t * 768 + 544 + f]); const f32x2 cs = CS[i];
            const unsigned w = cvt_pk_bf16(t1 * cs.x - t2 * cs.y, t1 * cs.y + t2 * cs.x);
#pragma unroll
            for (int hh = 0; hh < 16; ++hh) ((unsigned*)(KF + (size_t)t * 3072 + hh * 192 + 128))[f] = w; }
        GRID_BAR();
    }
    if (IN(3)) {
        DEF_GIDX();
        for (int r = gw; r < T * 4; r += NGW) { float* sp = SMEM + (size_t)r * 256; const f32x4 v = ((const f32x4*)sp)[lane];
            float mx = fmaxf(fmaxf(v[0], v[1]), fmaxf(v[2], v[3]));
#pragma unroll
            for (int o = 1; o < 64; o <<= 1) mx = fmaxf(mx, __shfl_xor(mx, o));
            const float e0 = fexp2(v[0] - mx), e1 = fexp2(v[1] - mx), e2 = fexp2(v[2] - mx), e3 = fexp2(v[3] - mx);
            const float inv = frcp(wave_sum((e0 + e1) + (e2 + e3)));
            u32x2 w; w.x = cvt_pk_bf16(e0 * inv, e1 * inv); w.y = cvt_pk_bf16(e2 * inv, e3 * inv);
            ((u32x2*)sp)[lane] = w; }
        __syncthreads();
        { const AttnArgs A{SBQ, SBK, SBV, ws + WS_Y8A, 1.f}; attn_phase<1>(lds, A, G, c); }
        __syncthreads();
        { const AttnArgs A{QMLA, KF, VV, ws + WS_Y8B, YB_SC}; attn_phase<0>(lds, A, G, c); }
        GRID_BAR();
    }
    if (IN(4)) {
        struct SchedPV : pg8::SchedB {
            __device__ __forceinline__ const char* pa(const Unit& u) const { return A + ((size_t)(u.z >> 2) * SEQ * 2048 + (size_t)(u.z & 3) * 512) * 2 + (size_t)u.pm * tA; }
            __device__ __forceinline__ const char* pb(const Unit& u) const { return B + (size_t)u.z * 512 * 256 * 2 + (size_t)u.pn * tB; }
        } S; S.init(SEQ, 512, 8, G, c, SMEM, MVT, 2048, 256, 0, 0);
        EpiMemPV E{ws + WS_Y8C};
        int kpv = 256; asm volatile("" : "+s"(kpv));
        pg8::gemm_phase<EpiMemPV, SchedPV>(lds, pg8::Gemm{kpv, 2048, 256}, S, E);
        GRID_BAR();
    }
    if (IN(5)) {
        pg8::SchedM S; S.nM = T / 256; S.nN = D / 256; S.G = G; S.c = c;
        S.ws = (const char*)ws; S.B = (const char*)WBR; S.o0 = 0; S.o1 = 0; S.o2 = 0;
        S.tA = (size_t)256 * 2048; S.tB = (size_t)256 * 2048; S.zB = (size_t)4096 * 2048;
        EpiMerge E{GATES, MERGED, ws + WS_MG8};
        pg8::gemm_phase_f8<EpiMerge, pg8::SchedM>(lds, pg8::Gemm{2048, 2048, 2048}, S, E);
        GRID_BAR();
    }
    if (IN(6)) {
        { pg8::SchedB S; S.init(T, D, 1, G, c, ws + WS_MG8, WOUT, D / 2, D / 2, 0, 0);
          EpiOut E{I_x, (float*)karg_in(20), H1B, SSQ_H, 1.f / (MG_SC * WOUT_SC)};
          pg8::gemm_phase_f8<EpiOut, pg8::SchedB>(lds, pg8::Gemm{D, D, D}, S, E); }
        DEF_GIDX();
        for (size_t w = gw; w < (size_t)NEXP * 4; w += NGW) {
            const size_t e = w >> 2; const int seg = (int)(w & 3);
            const f32x4* up = (const f32x4*)I_u_tab + e * (D / 4) + seg * 256 + lane; const f32x4* vp = (const f32x4*)I_v_tab + e * (D / 4) + seg * 256 + lane;
            f32x4 ua[4], va[4];
#pragma unroll
            for (int q = 0; q < 4; ++q) { ua[q] = up[64 * q]; va[q] = vp[64 * q]; }
#pragma unroll
            for (int q = 0; q < 4; ++q) {
                const f32x4 a = ua[q] * *(const f32x4*)(I_g_ffn + seg * 1024 + q * 256 + lane * 4) * PEER_SCU, p = va[q] * PEER_SCV;
                int du = __builtin_amdgcn_cvt_pk_fp8_f32(a[0], a[1], 0, false); du = __builtin_amdgcn_cvt_pk_fp8_f32(a[2], a[3], du, true);
                int dv = __builtin_amdgcn_cvt_pk_fp8_f32(p[0], p[1], 0, false); dv = __builtin_amdgcn_cvt_pk_fp8_f32(p[2], p[3], dv, true);
                const size_t dst = ((size_t)(seg * 4 + q) * NEXP + e) * 64 + lane;
                ((unsigned*)UTAB)[dst] = (unsigned)du; ((unsigned*)VTAB)[dst] = (unsigned)dv;
            }
        }
        GRID_BAR();
    }
    if (IN(7)) {
        pg8::SchedB S; S.init(T, 2048, 1, G, c, H1B, WPQ, D, D, 0, 0);
        EpiPQ E{SSQ_H, PQ};
        pg8::gemm_phase<EpiPQ, pg8::SchedB>(lds, pg8::Gemm{D, D, D}, S, E);
        GRID_BAR();
    }
    if (IN(8)) {
        constexpr int SCP = 129;
        LAS float* SC = (LAS float*)lds;
        LAS unsigned* LST = (LAS unsigned*)(lds + 2 * 128 * SCP * 4);
        LAS unsigned char* CT = lds + 2 * 128 * SCP * 4 + 128 * 33 * 4;
        if (tid < 50) { int id = 0, fi = 0, fj = 0; for (int i = 0; i < 16; ++i) for (int j = 0; j < 16 / (i + 1); ++j) { if (id == tid) { fi = i; fj = j; } ++id; } CT[2 * tid] = (unsigned char)fi; CT[2 * tid + 1] = (unsigned char)fj; }
        for (int un = c; un < 128 * 8; un += G) {
            const int tile = un >> 3, h = un & 7, tok0 = tile * 128;
            __syncthreads();
            {
                const int p = wave >> 2, tt = wave & 3, hi = lane >> 5;
                const bf16_t* qp = PQ + (size_t)(tok0 + 32 * tt + (lane & 31)) * 2048 + h * 256 + p * 128 + 8 * hi;
                bf16x8 af[8];
#pragma unroll
                for (int ks = 0; ks < 8; ++ks) af[ks] = *(const bf16x8*)(qp + 16 * ks);
#pragma unroll
                for (int nt = 0; nt < 4; ++nt) {
                    const bf16_t* kp = SKB + ((size_t)(h * 2 + p) * 128 + 32 * nt + (lane & 31)) * 128 + 8 * hi;
                    f32x16 acc;
#pragma unroll
                    for (int r = 0; r < 16; ++r) acc[r] = 0.f;
#pragma unroll
                    for (int ks = 0; ks < 8; ++ks) acc = __builtin_amdgcn_mfma_f32_32x32x16_bf16(af[ks], *(const bf16x8*)(kp + 16 * ks), acc, 0, 0, 0);
#pragma unroll
                    for (int r = 0; r < 16; ++r) SC[(p * 128 + 32 * tt + (r & 3) + 8 * (r >> 2) + 4 * hi) * SCP + 32 * nt + (lane & 31)] = acc[r];
                }
            }
            __syncthreads();
            if (tid < 256) {
                const int p = tid >> 7, tk = tid & 127;
                const LAS float* row = SC + (p * 128 + tk) * SCP;
                unsigned L[16];
#pragma unroll
                for (int s = 0; s < 16; ++s) L[s] = 0u;
#pragma unroll 4
                for (int n = 0; n < 128; ++n) {
                    unsigned u = __float_as_uint(row[n]); u = (u & 0x80000000u) ? ~u : (u | 0x80000000u);
                    unsigned xk = (u & ~127u) | (unsigned)(127 - n);
#pragma unroll
                    for (int s = 0; s < 16; ++s) { const unsigned hi2 = L[s] > xk ? L[s] : xk, lo2 = L[s] > xk ? xk : L[s]; L[s] = hi2; xk = lo2; }
                }
#pragma unroll
                for (int s = 0; s < 16; ++s) LST[tk * 33 + p * 16 + s] = L[s];
            } else {
                const u32x4* tu = (const u32x4*)UTAB + (size_t)un * 4096 + (tid - 256); const u32x4* tv = (const u32x4*)VTAB + (size_t)un * 4096 + (tid - 256);
                u32x4 ax = {0u, 0u, 0u, 0u};
#pragma unroll 8
                for (int q = 0; q < 16; ++q) { ax ^= tu[256 * q]; ax ^= tv[256 * q]; }
                if ((ax[0] ^ ax[1] ^ ax[2] ^ ax[3]) == 0x12345678u && ax[1] == 0x9abcdef0u) ((unsigned*)(ws + WS_CTL))[4096 + (tid & 255)] = ax[2];
            }
            __syncthreads();
            if (tid < 128) {
                const LAS unsigned* L = LST + tid * 33;
                unsigned Kk[16];
#pragma unroll
                for (int s = 0; s < 16; ++s) Kk[s] = 0u;
                float v0[16], v1[16];
#pragma unroll
                for (int s = 0; s < 16; ++s) { unsigned a = L[s] & ~127u, b = L[16 + s] & ~127u; a = (a & 0x80000000u) ? (a & 0x7fffffffu) : ~a; b = (b & 0x80000000u) ? (b & 0x7fffffffu) : ~b; v0[s] = __uint_as_float(a); v1[s] = __uint_as_float(b); }
                int id = 0;
#pragma unroll
                for (int i = 0; i < 16; ++i)
#pragma unroll
                    for (int j = 0; j < 16 / (i + 1); ++j) {
                        unsigned u = __float_as_uint(v0[i] + v1[j]); u = (u & 0x80000000u) ? ~u : (u | 0x80000000u);
                        unsigned xk = (u & ~63u) | (unsigned)(63 - id); ++id;
#pragma unroll
                        for (int s = 0; s < 16; ++s) { const unsigned hi2 = Kk[s] > xk ? Kk[s] : xk, lo2 = Kk[s] > xk ? xk : Kk[s]; Kk[s] = hi2; xk = lo2; }
                    }
                float val[16]; float sum = 0.f;
#pragma unroll
                for (int s = 0; s < 16; ++s) { unsigned a = Kk[s] & ~63u; a = (a & 0x80000000u) ? (a & 0x7fffffffu) : ~a; val[s] = __uint_as_float(a); }
#pragma unroll
                for (int s = 15; s >= 0; --s) { val[s] = fexp2((val[s] - val[0]) * LOG2E); sum += val[s]; }
                const float inv = 1.f / sum;
                u32x2* rp = ROUTE + (size_t)(tok0 + tid) * 128 + h * 16;
#pragma unroll
                for (int s = 0; s < 16; ++s) { const int cid = 63 - (int)(Kk[s] & 63u); const int ci = CT[2 * cid], cj = CT[2 * cid + 1];
                    const unsigned e = (127u - (L[ci] & 127u)) * 128u + (127u - (L[16 + cj] & 127u));
                    rp[s] = (u32x2){e, __float_as_uint(val[s] * inv)}; }
            }
        }
        GRID_BAR();
    }
    if (IN(9)) {
        LAS unsigned char* wl = lds + wave * 20480;
        LAS unsigned short* SE = (LAS unsigned short*)wl;
        LAS float* HA = (LAS float*)(wl + 1024);
        LAS unsigned char* HBp = wl + 3072;
        LAS unsigned char* RB = wl + 4096;
        LAS unsigned* TMP = (LAS unsigned*)RB;
        unsigned short* GS = (unsigned short*)(ws + WS_PQ);
        const unsigned sv_nloc = MISC[8], sv_nx = MISC[9];
        __syncthreads();
        const int l16 = lane & 15, lg = lane >> 4;
        const int rot = 2 * (c & 7);
#define WFENCE() asm volatile("s_waitcnt lgkmcnt(0)" ::: "memory")
#define H8C(x) __builtin_amdgcn_fmed3f((x) * H8_SC, -448.f, 448.f)
        for (int tg = c * NWAVES + wave; tg < T / 8; tg += G * NWAVES) {
            const int tb = tg * 8;
            WFENCE();
            GAS float* outp = (GAS float*)karg_in(20); const GAS float* gfin = (const GAS float*)I_g_fin;
#pragma unroll 1
            for (int pass = 0; pass < 2; ++pass) {
                const int ip0 = 0, tp = tb + 4 * pass;
                WFENCE();
#pragma unroll 1
                for (int i = 0; i < 4; ++i) {
                    const u32x2 r0 = ROUTE[(size_t)(tp + i) * 128 + lane], r1 = ROUTE[(size_t)(tp + i) * 128 + lane + 64];
                    const unsigned k0 = (r0.x << 7) | (unsigned)lane, k1 = (r1.x << 7) | (unsigned)(lane + 64);
                    TMP[lane] = k0; TMP[lane + 64] = k1;
                    WFENCE();
                    int ra = 0, rb = 0;
#pragma unroll 8
                    for (int m = 0; m < 128; ++m) { const unsigned km = TMP[m]; ra += km < k0 ? 1 : 0; rb += km < k1 ? 1 : 0; }
                    SE[i * 128 + ra] = (unsigned short)r0.x; SE[i * 128 + rb] = (unsigned short)r1.x;
                    GS[(size_t)(tp + i) * 128 + ra] = (unsigned short)cvt_pk_bf16(__uint_as_float(r0.y), 0.f); GS[(size_t)(tp + i) * 128 + rb] = (unsigned short)cvt_pk_bf16(__uint_as_float(r1.y), 0.f);
                    HA[i * 128 + lane] = 0.f; HA[i * 128 + lane + 64] = 0.f;
                    WFENCE();
                }
                {
                    const unsigned scl1 = 0x7f7f7f7fu;
                    const int nrow = l16;
                    const int fo0 = nrow * 256 + (((2 * lg) ^ nrow) * 16), fo1 = nrow * 256 + (((2 * lg + 1) ^ nrow) * 16);
                    const int hae = 4 * (l16 & 3) + (l16 >> 2);
                    int wb = 0, rb = 0;
#define CAT8(x, y) __builtin_shufflevector(__builtin_bit_cast(i32x4, x), __builtin_bit_cast(i32x4, y), 0, 1, 2, 3, 4, 5, 6, 7)
#define ISSUE_STEP(bq, rq, iq) do { const u32x2 ew2_ = *(const LAS u32x2*)(SE + (iq) * 128 + 16 * (rq) + 4 * lg); const unsigned ew_[4] = {ew2_.x & 0xffffu, ew2_.x >> 16, ew2_.y & 0xffffu, ew2_.y >> 16}; LAS unsigned char* dst_ = RB + wb * 4096; \
                        _Pragma("unroll") for (int q_ = 0; q_ < 4; ++q_) { const int n_ = 4 * q_ + lg; \
                            __builtin_amdgcn_global_load_lds((const unsigned*)((bq) + (size_t)ew_[q_] * 256 + ((l16 ^ n_) * 16)), (LAS unsigned*)(dst_ + q_ * 1024), 16, 0, 0); } \
                        wb = (wb + 1) & 3; } while (0)
                    const unsigned char* ub = (const unsigned char*)UTAB + (size_t)rot * NEXP * 256;
                    ISSUE_STEP(ub, 0, 0); ISSUE_STEP(ub, 0, 1); ISSUE_STEP(ub, 0, 2);
#pragma unroll 1
                    for (int j = 0; j < 16; ++j) {
                        { const int je = (j + rot) & 15; const u32x4 ha = *(const u32x4*)(H1B + (size_t)(tp + lg) * D + je * 256 + l16 * 16), hb = *(const u32x4*)(H1B + (size_t)(tp + lg) * D + je * 256 + l16 * 16 + 8);
                          u32x4 pk;
#pragma unroll
                          for (int q = 0; q < 2; ++q) {
                              int w0 = __builtin_amdgcn_cvt_pk_fp8_f32(H8C(bf_lo(ha[2 * q])), H8C(bf_hi(ha[2 * q])), 0, false); w0 = __builtin_amdgcn_cvt_pk_fp8_f32(H8C(bf_lo(ha[2 * q + 1])), H8C(bf_hi(ha[2 * q + 1])), w0, true);
                              int w1 = __builtin_amdgcn_cvt_pk_fp8_f32(H8C(bf_lo(hb[2 * q])), H8C(bf_hi(hb[2 * q])), 0, false); w1 = __builtin_amdgcn_cvt_pk_fp8_f32(H8C(bf_lo(hb[2 * q + 1])), H8C(bf_hi(hb[2 * q + 1])), w1, true);
                              pk[q] = (unsigned)w0; pk[2 + q] = (unsigned)w1; }
                          WFENCE();
                          *(LAS u32x4*)(HBp + lg * 256 + l16 * 16) = pk;
                          WFENCE(); }
                        i32x8 hf[4][2];
#pragma unroll
                        for (int i = 0; i < 4; ++i)
#pragma unroll
                            for (int kb = 0; kb < 2; ++kb) hf[i][kb] = CAT8(*(const LAS u32x4*)(HBp + i * 256 + kb * 128 + lg * 32), *(const LAS u32x4*)(HBp + i * 256 + kb * 128 + lg * 32 + 16));
                        const unsigned char* nub = j < 15 ? (const unsigned char*)UTAB + (size_t)((j + 1 + rot) & 15) * NEXP * 256 : ub;
#pragma unroll 1
                        for (int r = 0; r < 8; ++r) {
                            const unsigned char* pb = r == 7 ? nub : ub; const int rn = (r + 1) & 7;
#pragma unroll
                            for (int i = 0; i < 4; ++i) {
                                if (i + 3 < 4) ISSUE_STEP(ub, r, i + 3); else ISSUE_STEP(pb, rn, i + 3 - 4);
                                asm volatile("s_waitcnt vmcnt(12)" ::: "memory");
                                LAS unsigned char* src = RB + rb * 4096; rb = (rb + 1) & 3;
                                const u32x4 x0 = *(const LAS u32x4*)(src + fo0), x1 = *(const LAS u32x4*)(src + fo1), x2 = *(const LAS u32x4*)(src + (fo0 ^ 128)), x3 = *(const LAS u32x4*)(src + (fo1 ^ 128));
                                f32x4 dd;
                                asm volatile("s_nop 1\n\tv_mfma_f32_16x16x128_f8f6f4 %0, %1, %2, 0" : "=&v"(dd) : "v"(hf[i][0]), "v"(CAT8(x0, x1)));
                                asm volatile("v_mfma_f32_16x16x128_f8f6f4 %0, %1, %2, %0\n\ts_nop 15\n\ts_nop 3" : "+v"(dd) : "v"(hf[i][1]), "v"(CAT8(x2, x3)));
                                if (lg == 0) asm volatile("ds_add_f32 %0, %1" :: "v"((unsigned)(size_t)(HA + i * 128 + 16 * r + hae)), "v"(dd[0]) : "memory");
                                __builtin_amdgcn_sched_barrier(0);
                            }
                        }
                        ub = nub;
                    }
                    asm volatile("s_waitcnt vmcnt(0)" ::: "memory");
#undef ISSUE_STEP
#undef CAT8
                }
                WFENCE();
#pragma unroll 1
                for (int i = 0; i < 4; ++i) {
                    const float r2 = __builtin_amdgcn_rsqf(slot_sum<64>(SSQ_H + (size_t)(tp + i) * 64) * (1.f / 4096.f) + EPS) * (1.f / (PEER_SCU * H8_SC));
#pragma unroll
                    for (int hq = 0; hq < 2; ++hq) { const int e = lane + 64 * hq, q = i * 128 + e; const float z = HA[q] * r2;
                        const float av = 0.5f * z * (1.f + erff(z * 0.70710678118654752f)) * __uint_as_float((unsigned)GS[(size_t)(tp + i) * 128 + e] << 16) * A8_SC;
                        HBp[i * 128 + ((e & ~15) | ((e & 3) << 2) | ((e >> 2) & 3))] = (unsigned char)__builtin_amdgcn_cvt_pk_fp8_f32(__builtin_amdgcn_fmed3f(av, -448.f, 448.f), 0.f, 0, false); }
                }
                WFENCE();
                if (G * NWAVES * 8 == T) { asm volatile("s_waitcnt vmcnt(0)" ::: "memory"); __syncthreads(); if (tid == 0) { MISC[8] = sv_nloc; MISC[9] = sv_nx; } GRID_BAR(); }
                float ssq2[2] = {0.f, 0.f};
                const int th = lg >> 1, hb = lg & 1;
                {
                    LAS unsigned char* HB1 = (LAS unsigned char*)HA;
                    const int rho = 4 * lg + (l16 >> 2), pp = l16 & 3;
                    unsigned toff[8];
#pragma unroll
                    for (int g = 0; g < 8; ++g) toff[g] = (unsigned)(size_t)RB + (unsigned)(rho * 256 + (((g ^ (rho & 7)) << 5) | ((pp >> 1) << 4) | ((pp & 1) << 3)));
                    const unsigned selLo = (l16 & 1) ? 0x010c000cu : 0x0c010c00u, selHi = (l16 & 1) ? 0x030c020cu : 0x0c030c02u;
                    const int cm = (l16 >> 1) & 3;
                    const unsigned km0 = cm == 0 ? ~0u : 0u, km1 = cm == 1 ? ~0u : 0u, km2 = cm == 2 ? ~0u : 0u, km3 = cm == 3 ? ~0u : 0u;
                    const unsigned scl1 = 0x7f7f7f7fu;
                    int wb = 0, rb = 0;
#define ISSUE_STEPV(bq, rq, iq) do { const u32x2 ew2_ = *(const LAS u32x2*)(SE + (iq) * 128 + 16 * (rq) + 4 * lg); const unsigned ew_[4] = {ew2_.x & 0xffffu, ew2_.x >> 16, ew2_.y & 0xffffu, ew2_.y >> 16}; LAS unsigned char* dst_ = RB + wb * 4096; \
                        _Pragma("unroll") for (int q_ = 0; q_ < 4; ++q_) { const int n_ = 4 * q_ + lg; \
                            __builtin_amdgcn_global_load_lds((const unsigned*)((bq) + (size_t)ew_[q_] * 256 + ((l16 ^ ((n_ & 7) * 2)) * 16)), (LAS unsigned*)(dst_ + q_ * 1024), 16, 0, 0); } \
                        wb = (wb + 1) & 3; } while (0)
#define ISSUE_H1(jq) do { _Pragma("unroll") for (int t_ = 0; t_ < 2; ++t_) \
                        __builtin_amdgcn_global_load_lds((const unsigned*)(H1B + (size_t)(tp + 2 * t_ + (lane >> 5)) * D + (jq) * 256 + (lane & 31) * 8), (LAS unsigned*)(HB1 + t_ * 1024), 16, 0, 0); } while (0)
#define CAT8(x, y) __builtin_shufflevector(__builtin_bit_cast(i32x4, x), __builtin_bit_cast(i32x4, y), 0, 1, 2, 3, 4, 5, 6, 7)
#define CAT4(x, y) __builtin_shufflevector(x, y, 0, 1, 2, 3)
                    const unsigned char* vb = (const unsigned char*)VTAB + (size_t)rot * NEXP * 256;
                    ISSUE_STEPV(vb, 0, 0); ISSUE_STEPV(vb, 0, 1); ISSUE_STEPV(vb, 0, 2); ISSUE_H1(rot);
#pragma unroll 1
                    for (int j = 0; j < 16; ++j) {
                        f32x4 acc[4][2];
#pragma unroll
                        for (int i = 0; i < 4; ++i) { acc[i][0] = (f32x4){0.f, 0.f, 0.f, 0.f}; acc[i][1] = (f32x4){0.f, 0.f, 0.f, 0.f}; }
                        const unsigned char* nvb = j < 15 ? (const unsigned char*)VTAB + (size_t)((j + 1 + rot) & 15) * NEXP * 256 : vb; const int je = (j + rot) & 15;
#pragma unroll 1
                        for (int r = 0; r < 8; ++r) {
                            const unsigned char* pb = r == 7 ? nvb : vb; const int rn = (r + 1) & 7;
#pragma unroll
                            for (int i = 0; i < 4; ++i) {
                                if (i + 3 < 4) ISSUE_STEPV(vb, r, i + 3); else ISSUE_STEPV(pb, rn, i + 3 - 4);
                                const unsigned aw = *(const LAS unsigned*)(HBp + i * 128 + 16 * r + 4 * lg);
                                asm volatile("s_waitcnt vmcnt(12)" ::: "memory");
                                const unsigned so = (unsigned)rb * 4096u; rb = (rb + 1) & 3;
                                u32x2 bq[8];
#pragma unroll
                                for (int g = 0; g < 8; ++g) asm volatile("ds_read_b64_tr_b16 %0, %1" : "=v"(bq[g]) : "v"(toff[g] + so) : "memory");
                                const unsigned alo = __builtin_amdgcn_perm(aw, aw, selLo), ahi = __builtin_amdgcn_perm(aw, aw, selHi);
                                const i32x8 aop = {(int)(alo & km0), (int)(ahi & km0), (int)(alo & km1), (int)(ahi & km1), (int)(alo & km2), (int)(ahi & km2), (int)(alo & km3), (int)(ahi & km3)};
                                asm volatile("s_waitcnt lgkmcnt(0)" : "+v"(bq[0]), "+v"(bq[1]), "+v"(bq[2]), "+v"(bq[3]), "+v"(bq[4]), "+v"(bq[5]), "+v"(bq[6]), "+v"(bq[7]) :: "memory");
                                asm volatile("s_nop 1\n\tv_mfma_f32_16x16x128_f8f6f4 %0, %1, %2, %0" : "+v"(acc[i][0]) : "v"(aop), "v"(CAT8(CAT4(bq[0], bq[1]), CAT4(bq[2], bq[3]))));
                                asm volatile("s_nop 1\n\tv_mfma_f32_16x16x128_f8f6f4 %0, %1, %2, %0" : "+v"(acc[i][1]) : "v"(aop), "v"(CAT8(CAT4(bq[4], bq[5]), CAT4(bq[6], bq[7]))));
                                __builtin_amdgcn_sched_barrier(0);
                            }
                        }
                        vb = nvb;
                        asm volatile("s_nop 15\n\ts_nop 3" : "+v"(acc[0][0]), "+v"(acc[0][1]), "+v"(acc[1][0]), "+v"(acc[1][1]), "+v"(acc[2][0]), "+v"(acc[2][1]), "+v"(acc[3][0]), "+v"(acc[3][1]));
#pragma unroll
                        for (int tt = 0; tt < 2; ++tt)
#pragma unroll
                            for (int G = 0; G < 2; ++G) {
                                const f32x4 va_ = acc[tt][G] + 0.f, vb_ = acc[2 + tt][G] + 0.f; f32x4 v;
#pragma unroll
                                for (int e_ = 0; e_ < 4; ++e_) v[e_] = th ? vb_[e_] : va_[e_];
                                const int ch = 32 * (4 * G + 2 * hb) + 2 * l16;
                                bf16_t* op = H1B + (size_t)(tp + 2 * th + tt) * D + je * 256 + ch;
                                const unsigned ha = *(const LAS unsigned*)(HB1 + (2 * th + tt) * 512 + ch * 2), hc = *(const LAS unsigned*)(HB1 + (2 * th + tt) * 512 + (ch + 32) * 2);
                                f32x2 h0 = {bf_lo(ha) + v[0] * (1.f / (A8_SC * PEER_SCV)), bf_hi(ha) + v[1] * (1.f / (A8_SC * PEER_SCV))};
                                f32x2 h1v = {bf_lo(hc) + v[2] * (1.f / (A8_SC * PEER_SCV)), bf_hi(hc) + v[3] * (1.f / (A8_SC * PEER_SCV))};
                                ssq2[tt] += h0.x * h0.x + h0.y * h0.y + h1v.x * h1v.x + h1v.y * h1v.y;
                                *(unsigned*)op = cvt_pk_bf16(h0.x, h0.y); *(unsigned*)(op + 32) = cvt_pk_bf16(h1v.x, h1v.y); }
                        WFENCE();
                        if (j < 15) ISSUE_H1((j + 1 + rot) & 15);
                    }
                    asm volatile("s_waitcnt vmcnt(0)" ::: "memory");
#undef ISSUE_STEPV
#undef ISSUE_H1
#undef CAT8
#undef CAT4
                }
                float rnt[4];
#pragma unroll
                for (int tt = 0; tt < 2; ++tt) {
                    float sq = row16_sum(ssq2[tt] + 0.f); sq += __shfl_xor(sq, 16);
                    const float rn = __builtin_amdgcn_rsqf(sq * (1.f / 4096.f) + EPS);
                    rnt[tt] = __int_as_float(__builtin_amdgcn_readlane(__float_as_int(rn), 0)); rnt[2 + tt] = __int_as_float(__builtin_amdgcn_readlane(__float_as_int(rn), 32));
                }
#pragma unroll 1
                for (int i = 0; i < 4; ++i) {
                    const float rn = i == 0 ? rnt[0] : (i == 1 ? rnt[1] : (i == 2 ? rnt[2] : rnt[3]));
                    const bf16_t* hp2 = H1B + (size_t)(tp + i) * D + lane * 8; GAS float* op = outp + (size_t)(tp + i) * D + lane * 8; const GAS float* gp = gfin + lane * 8;
                    u32x4 hw[8];
#pragma unroll
                    for (int it = 0; it < 8; ++it) hw[it] = *(const u32x4*)(hp2 + it * 512);
#pragma unroll
                    for (int it = 0; it < 8; ++it) {
                        const f32x4 g0 = *(const GAS f32x4*)(gp + it * 512), g1 = *(const GAS f32x4*)(gp + it * 512 + 4);
                        const f32x4 a0 = {bf_lo(hw[it].x), bf_hi(hw[it].x), bf_lo(hw[it].y), bf_hi(hw[it].y)}, a1 = {bf_lo(hw[it].z), bf_hi(hw[it].z), bf_lo(hw[it].w), bf_hi(hw[it].w)};
                        __builtin_nontemporal_store(a0 * rn * g0, (GAS f32x4*)(op + it * 512)); __builtin_nontemporal_store(a1 * rn * g1, (GAS f32x4*)(op + it * 512 + 4)); }
                }
            }
        }
#undef WFENCE
#undef H8C
    }
#undef IN
#undef GRID_BAR
}


extern "C" void kernel_launch(void* const* d_in, const int* in_sizes, int n_in, void* d_out, int out_size, void* d_ws, size_t ws_size, hipStream_t stream) {
    static int grid = 0;
    if (grid == 0) {
        if (n_in != 19 || out_size != T * D || ws_size < WS_END2) { fprintf(stderr, "kernel_launch: unexpected shapes (n_in %d out %d ws %zu need %zu)\n", n_in, out_size, ws_size, (size_t)WS_END2); grid = -1; return; }
        int dev = 0, cus = 0, per_cu = 0;
        if (hipGetDevice(&dev) != hipSuccess || hipDeviceGetAttribute(&cus, hipDeviceAttributeMultiprocessorCount, dev) != hipSuccess) { grid = -1; return; }
        if (hipFuncSetAttribute((const void*)hybrid_fwd, hipFuncAttributeMaxDynamicSharedMemorySize, LDS_BYTES) != hipSuccess) { fprintf(stderr, "kernel_launch: hipFuncSetAttribute failed\n"); grid = -1; return; }
        if (hipOccupancyMaxActiveBlocksPerMultiprocessor(&per_cu, (const void*)hybrid_fwd, NTHREADS, LDS_BYTES) != hipSuccess || per_cu < 1) { fprintf(stderr, "kernel_launch: occupancy query says %d\n", per_cu); }
        (void)hipGetLastError();
        grid = cus;
    }
    if (grid < 0) return;
    (void)hipMemsetAsync((char*)d_ws + WS_CTL, 0, CTL_ZERO_BYTES, stream);
    Args a{};
    for (int i = 0; i < 19; ++i) a.in[i] = (const float*)d_in[i];
    a.pos = (const int*)d_in[2]; a.out = (float*)d_out; a.ws = (unsigned char*)d_ws;
#ifndef LAUNCH_SEQ
#define LAUNCH_SEQ {0, 10}
#endif
    static const int seq[][2] = {LAUNCH_SEQ};
    constexpr int nseq = (int)(sizeof(seq) / sizeof(seq[0]));
    for (int li = 0; li < nseq; ++li) { a.ph_lo = seq[li][0]; a.ph_hi = seq[li][1]; a.li = li; a.bar_on = (seq[li][1] - seq[li][0] > 1) ? 1 : 0;
        hipLaunchKernelGGL(hybrid_fwd, dim3(grid), dim3(NTHREADS), LDS_BYTES, stream, a); }

}
```

```cpp
#include <hip/hip_runtime.h>
#include <cstdio>
#include <cstdint>

#ifndef N_LAUNCHES
#define N_LAUNCHES 1
#endif

#define LAS __attribute__((address_space(3)))
#define GAS __attribute__((address_space(1)))
typedef unsigned short bf16_t;
typedef short bf16x8 __attribute__((ext_vector_type(8)));
typedef short s16x4 __attribute__((ext_vector_type(4)));
typedef float f32x4 __attribute__((ext_vector_type(4)));
typedef float f32x2 __attribute__((ext_vector_type(2)));
typedef float f32x16 __attribute__((ext_vector_type(16)));
typedef unsigned u32x4 __attribute__((ext_vector_type(4)));
typedef unsigned u32x2 __attribute__((ext_vector_type(2)));
typedef __bf16 bf2_t __attribute__((ext_vector_type(2)));
typedef int i32x4 __attribute__((ext_vector_type(4)));
typedef int i32x8 __attribute__((ext_vector_type(8)));

constexpr int T = 16384, SEQ = 8192, D = 4096;
constexpr int NPROJ = 22272;
constexpr int IN_COLS = 22080;
constexpr int NEXP = 16384;
constexpr float EPS = 1e-6f;
constexpr float LOG2E = 1.4426950408889634f;
constexpr float C_SB = LOG2E * 0.08838834764831845f;
constexpr float C_MLA = LOG2E * 0.07216878364870322f;
constexpr float C_MEM = LOG2E * 0.04419417382415922f;
constexpr float SB_DONE = -160.f;
constexpr float WG8_SC = 64.f;
constexpr float YB_SC = 16.f, YC_SC = 8.f, WBR_SC = 32.f, MG_SC = 4.f, WOUT_SC = 64.f;
constexpr int NPROJ_BF = 7936, NGATE = 12288, NPROJ_F8 = 2048 + NGATE;
constexpr float MV_SC = 16.f, P8_SC = 256.f, BT_SC = 64.f;
constexpr float H8_SC = 8.f;
constexpr float A8_SC = 64.f;
constexpr float PEER_SCU = 1024.f, PEER_SCV = 16.f;

constexpr size_t MiB = 1u << 20;
constexpr size_t WS_CTL = 0, CTL_ZERO_BYTES = 1 * MiB;
constexpr size_t WS_RS = 1 * MiB;
constexpr size_t WS_SSQ_DQ = 1 * MiB + 512 * 1024;
constexpr size_t WS_SSQ_DKV = 2 * MiB + 512 * 1024;
constexpr size_t WS_SSQ_H = 3 * MiB;
constexpr size_t WS_CS = 8 * MiB;
constexpr size_t WS_MEMN = 12 * MiB;
constexpr size_t WS_MK = 16 * MiB;
constexpr size_t WS_MVT = 18 * MiB;
constexpr size_t WS_SKB = 20 * MiB;
constexpr size_t WS_WUQ = 22 * MiB;
constexpr size_t WS_WUKV = 28 * MiB;
constexpr size_t WS_WMKV = 32 * MiB;
constexpr size_t WS_WBR = 64 * MiB;
constexpr size_t WS_WOUT = 112 * MiB;
constexpr size_t WS_WPQ = 144 * MiB;
constexpr size_t WS_YMLA = 160 * MiB;
constexpr size_t WS_R0 = 224 * MiB;
constexpr size_t WS_XB = WS_R0;
constexpr size_t WS_WIN = WS_R0 + 128 * MiB;
constexpr size_t WS_QMLA = WS_R0;
constexpr size_t WS_KF = WS_R0 + 96 * MiB;
constexpr size_t WS_VV = WS_R0 + 192 * MiB;
constexpr size_t WS_H1B = WS_R0;
constexpr size_t WS_ROUTE = WS_R0 + 128 * MiB;
constexpr size_t WS_R1 = 526 * MiB;
constexpr size_t WS_SBQ = WS_R1;
constexpr size_t WS_SBK = WS_R1 + 64 * MiB;
constexpr size_t WS_SBV = WS_R1 + 128 * MiB;
constexpr size_t WS_DQ = WS_R1 + 192 * MiB;
constexpr size_t WS_DKV = WS_R1 + 224 * MiB;
constexpr size_t WS_MEMQ = WS_R1 + 248 * MiB;
constexpr size_t WS_GATES = WS_R1 + 312 * MiB;
constexpr size_t WS_MERGED = WS_SBK;
constexpr size_t WS_PQ = WS_SBQ;
constexpr size_t WS_UTAB = WS_GATES;
constexpr size_t WS_VTAB = WS_GATES + 128 * MiB;
constexpr size_t WS_SMEM = WS_GATES + 384 * MiB;
constexpr size_t WS_END = WS_SMEM + 64 * MiB;
constexpr size_t WS_XB8 = WS_END;
constexpr size_t WS_WIN8 = WS_R0 + 206 * MiB;
constexpr size_t WS_END2 = WS_XB8 + 64 * MiB;
constexpr size_t WS_BT = WS_WMKV;
constexpr size_t WS_END3 = WS_END2;
constexpr size_t WS_Y8A = WS_XB8;
constexpr size_t WS_Y8B = WS_XB8 + 32 * MiB;
constexpr size_t WS_Y8C = WS_YMLA;
constexpr size_t WS_MG8 = WS_R0 + 128 * MiB;

constexpr int NWAVES = 8, NTHREADS = 512;
constexpr int LDS_BYTES = 163840;
constexpr int MISC_OFF = LDS_BYTES - 64;

__device__ __forceinline__ unsigned cvt_pk_bf16(float lo, float hi) { unsigned r; asm volatile("v_cvt_pk_bf16_f32 %0, %1, %2" : "=v"(r) : "v"(lo), "v"(hi)); return r; }
__device__ __forceinline__ float bf_lo(unsigned u) { return __uint_as_float(u << 16); }
__device__ __forceinline__ float bf_hi(unsigned u) { return __uint_as_float(u & 0xffff0000u); }
__device__ __forceinline__ float fexp2(float x) { return __builtin_amdgcn_exp2f(x); }
__device__ __forceinline__ float flog2(float x) { return __builtin_amdgcn_logf(x); }
__device__ __forceinline__ float frcp(float x) { return __builtin_amdgcn_rcpf(x); }
__device__ __forceinline__ float dot2_bf16(unsigned a, unsigned b, float acc) { return __builtin_amdgcn_fdot2_f32_bf16(__builtin_bit_cast(bf2_t, a), __builtin_bit_cast(bf2_t, b), acc, false); }
template <int CTRL> __device__ __forceinline__ float dpp_add(float x) { return x + __builtin_bit_cast(float, __builtin_amdgcn_update_dpp(0, __builtin_bit_cast(int, x), CTRL, 0xf, 0xf, false)); }
__device__ __forceinline__ float row16_sum(float x) { x = dpp_add<0x128>(x); x = dpp_add<0x141>(x); x = dpp_add<0x4E>(x); return dpp_add<0xB1>(x); }
__device__ __forceinline__ float xor32_max(float x) { const unsigned b = __float_as_uint(x); auto rr = __builtin_amdgcn_permlane32_swap(b, b, false, false); return fmaxf(__uint_as_float(rr[0]), __uint_as_float(rr[1])); }
__device__ __forceinline__ float xor32_sum(float x) { const unsigned b = __float_as_uint(x); auto rr = __builtin_amdgcn_permlane32_swap(b, b, false, false); return __uint_as_float(rr[0]) + __uint_as_float(rr[1]); }
__device__ __forceinline__ float xor32_partner(float x, int hi) { const unsigned b = __float_as_uint(x); auto rr = __builtin_amdgcn_permlane32_swap(b, b, false, false); return __uint_as_float(hi ? rr[0] : rr[1]); }
__device__ __forceinline__ float wave_sum(float v) {
#pragma unroll
    for (int o = 1; o < 64; o <<= 1) v += __shfl_xor(v, o);
    return v;
}
#define LDS_WAIT() asm volatile("s_waitcnt lgkmcnt(0)" ::: "memory")
#define VM_WAIT() asm volatile("s_waitcnt vmcnt(0)" ::: "memory")

namespace pg8 {
constexpr int BM = 256, BK = 64, HALF = 128, HTB = HALF * BK * 2, STAGE_BYTES = 8 * HTB, NXCD = 8, WGM = 8;
__host__ __device__ __forceinline__ int lds_byte(int r, int c) { const int st = (r >> 4) * 2 + (c >> 5), rr = r & 15, cc = c & 31, ob = rr * 64 + cc * 2; return st * 1024 + (ob ^ (((ob >> 9) & 1) << 5)); }
__host__ __device__ __forceinline__ void stage_rc(int b, int& R, int& C) { const int st = b / 1024, sb = b % 1024, swz = sb ^ (((sb >> 9) & 1) << 5); R = (st >> 1) * 16 + swz / 64; C = (st & 1) * 32 + (swz % 64) / 2; }
__host__ __device__ __forceinline__ int perm32(int rho) { const int n = rho >> 4, i = rho & 15; return 8 * (i >> 2) + 4 * n + (i & 3); }

struct Unit { int pm, pn, z; };
struct Gemm { int K, lda, ldb; };

__device__ __forceinline__ void tile_of(int wgid, int nM, int nN, int& pm, int& pn) {
    const int nwg = nM * nN;
    { const int q = nwg / NXCD, r = nwg % NXCD, xcd = wgid % NXCD, off = wgid / NXCD; wgid = (xcd < r ? xcd * (q + 1) : r * (q + 1) + (xcd - r) * q) + off; }
    const int nig = WGM * nN, gid = wgid / nig, fm = gid * WGM, gsz = (nM - fm) < WGM ? (nM - fm) : WGM;
    pm = fm + ((wgid % nig) % gsz); pn = (wgid % nig) / gsz;
}
struct SchedB {
    int nM, nN, nz, G, c; const char* A; const char* B; size_t tA, tB, zA, zB;
    __device__ __forceinline__ void init(int M, int N, int nz_, int G_, int c_, const void* A_, const void* B_, int lda, int ldb, size_t zA_, size_t zB_) {
        nM = M / BM; nN = N / BM; nz = nz_; G = G_; c = c_; A = (const char*)A_; B = (const char*)B_; tA = (size_t)BM * lda * 2; tB = (size_t)BM * ldb * 2; zA = zA_; zB = zB_; }
    __device__ __forceinline__ bool next(int i, Unit& u) const {
        const long L = (long)i * G + c; const int per = nM * nN; if (L >= (long)per * nz) return false;
        u.z = (int)(L / per); tile_of((int)(L % per), nM, nN, u.pm, u.pn); return true; }
    __device__ __forceinline__ const char* pa(const Unit& u) const { return A + (size_t)u.z * zA + (size_t)u.pm * tA; }
    __device__ __forceinline__ const char* pb(const Unit& u) const { return B + (size_t)u.z * zB + (size_t)u.pn * tB; }
    __device__ __forceinline__ int nt(const Unit&, int dflt) const { return dflt; }
};
struct SchedM {
    int nM, nN, G, c; const char* ws; const char* B; const char* BT; size_t tA, tB, zB; size_t o0, o1, o2;
    __device__ __forceinline__ bool next(int i, Unit& u) const {
        const long L = (long)(i / 3) * G + c; if (L >= (long)nM * nN) return false;
        u.z = i % 3; tile_of((int)L, nM, nN, u.pm, u.pn); return true; }
    __device__ __forceinline__ const char* pa(const Unit& u) const { const size_t off = (u.z == 0 ? (size_t)WS_Y8A : (u.z == 1 ? (size_t)WS_Y8B : (size_t)WS_Y8C)); return ws + off + (size_t)u.pm * tA; }
    __device__ __forceinline__ const char* pb(const Unit& u) const { return u.z == 2 ? BT + (size_t)(u.pm / (SEQ / 256)) * ((size_t)4096 * 2048) + (size_t)u.pn * tB : B + (size_t)u.z * zB + (size_t)u.pn * tB; }
    __device__ __forceinline__ int nt(const Unit& u, int dflt) const { return u.z == 2 ? 8 : dflt; }
};

template <class Epi, class Sched, bool ALIGN_EPI = true>
__device__ __forceinline__ void gemm_phase(LAS unsigned char* lds, const Gemm g, const Sched& S, const Epi& E) {
    const int tid = threadIdx.x, wid = __builtin_amdgcn_readfirstlane(tid >> 6), lane = tid & 63, wr = wid >> 2, wc = wid & 3, fr = lane & 15, fq = lane >> 4;
    const int K = g.K, nt = K / BK;
    unsigned voffA[2], voffB[2];
#pragma unroll
    for (int i = 0; i < 2; ++i) { int R, C; stage_rc(tid * 16 + i * 8192, R, C); const int Rb = Epi::PERM ? ((R & ~31) + perm32(R & 31)) : R;
        voffA[i] = (unsigned)(R * g.lda + C) * 2u; voffB[i] = (unsigned)(Rb * g.ldb + C) * 2u; }
    const size_t kstep = (size_t)(BK * 2);
    const size_t hsA = (size_t)HALF * g.lda * 2, hsB = (size_t)HALF * g.ldb * 2;
    const unsigned ldsw = (unsigned)wid * 1024u;
    const int aoff = lds_byte(wr * 64 + fr, fq * 8), boff = lds_byte(wc * 32 + fr, fq * 8);
#define PG8_SA(b, h) (((b) * 2 + (h)) * HTB)
#define PG8_SB(b, h) ((4 + (b) * 2 + (h)) * HTB)
#define PG8_STAGE(bufoff, gbase, voff) do { _Pragma("unroll") for (int _i = 0; _i < 2; ++_i) \
        __builtin_amdgcn_global_load_lds((const unsigned*)((const char*)(gbase) + (voff)[_i]), (LAS unsigned*)(lds + (bufoff) + ldsw + _i * 8192), 16, 0, 0); } while (0)
#define PG8_LDA(dst, b, h) do { _Pragma("unroll") for (int m = 0; m < 4; ++m) _Pragma("unroll") for (int k = 0; k < 2; ++k) dst[m][k] = *(const LAS bf16x8*)(lds + PG8_SA(b, h) + aoff + m * 2048 + k * 1024); } while (0)
#define PG8_LDB(dst, b, h) do { _Pragma("unroll") for (int n = 0; n < 2; ++n) _Pragma("unroll") for (int k = 0; k < 2; ++k) dst[n][k] = *(const LAS bf16x8*)(lds + PG8_SB(b, h) + boff + n * 2048 + k * 1024); } while (0)
#define PG8_MMA(ai, bj, At, Bt) do { __builtin_amdgcn_s_setprio(1); _Pragma("unroll") for (int m = 0; m < 4; ++m) _Pragma("unroll") for (int n = 0; n < 2; ++n) _Pragma("unroll") for (int k = 0; k < 2; ++k) \
        acc[ai][bj][m][n] = __builtin_amdgcn_mfma_f32_16x16x32_bf16(Bt[n][k], At[m][k], acc[ai][bj][m][n], 0, 0, 0); __builtin_amdgcn_s_setprio(0); } while (0)
#define PG8_WAIT_V(n) asm volatile("s_waitcnt vmcnt(" #n ")" ::: "memory")
#define PG8_WAIT_L(n) asm volatile("s_waitcnt lgkmcnt(" #n ")" ::: "memory")
#define PG8_BAR __builtin_amdgcn_s_barrier()
#define PG8_SCHED __builtin_amdgcn_sched_barrier(0)
    Unit cur, nxt; int ui = 0;
    if (!S.next(0, cur)) return;
    f32x4 acc[2][2][4][2];
#pragma unroll
    for (int a = 0; a < 2; ++a)
#pragma unroll
        for (int b = 0; b < 2; ++b)
#pragma unroll
            for (int m = 0; m < 4; ++m)
#pragma unroll
                for (int n = 0; n < 2; ++n) acc[a][b][m][n] = (f32x4){0.f, 0.f, 0.f, 0.f};
    bf16x8 At[4][2], B0[2][2], B1[2][2];
    const char* cA = S.pa(cur); const char* cB = S.pb(cur);
    PG8_STAGE(PG8_SB(0, 0), cB, voffB); PG8_STAGE(PG8_SB(0, 1), cB + hsB, voffB); PG8_STAGE(PG8_SA(0, 0), cA, voffA); PG8_STAGE(PG8_SA(0, 1), cA + hsA, voffA);
    if (wr == 1) PG8_BAR;
    PG8_WAIT_V(2); PG8_BAR;
    PG8_STAGE(PG8_SB(1, 0), cB + kstep, voffB); PG8_STAGE(PG8_SA(1, 0), cA + kstep, voffA); PG8_STAGE(PG8_SB(1, 1), cB + hsB + kstep, voffB);
    PG8_WAIT_V(6); PG8_BAR;
    for (;;) {
        const bool has_next = S.next(ui + 1, nxt);
        const char* nA = has_next ? S.pa(nxt) : cA; const char* nB = has_next ? S.pb(nxt) : cB;
        for (int t = 0; t < nt; t += 2) {
            const bool last = (t == nt - 2);
            const char* a1 = cA + (size_t)(t + 1) * kstep;
            const char* a2 = last ? nA : cA + (size_t)(t + 2) * kstep; const char* b2 = last ? nB : cB + (size_t)(t + 2) * kstep;
            const char* a3 = a2 + kstep; const char* b3 = b2 + kstep;
            PG8_LDB(B0, 0, 0); PG8_LDB(B1, 0, 1); PG8_SCHED; PG8_LDA(At, 0, 0); PG8_STAGE(PG8_SA(1, 1), a1 + hsA, voffA);
            PG8_WAIT_V(8); PG8_WAIT_L(0); PG8_BAR; PG8_MMA(0, 0, At, B0); PG8_MMA(0, 1, At, B1); PG8_BAR; PG8_SCHED;
            PG8_LDA(At, 0, 1); PG8_STAGE(PG8_SB(0, 0), b2, voffB); PG8_STAGE(PG8_SB(0, 1), b2 + hsB, voffB); PG8_STAGE(PG8_SA(0, 0), a2, voffA);
            PG8_WAIT_V(8); PG8_WAIT_L(0); PG8_BAR; PG8_MMA(1, 0, At, B0); PG8_MMA(1, 1, At, B1); PG8_BAR; PG8_SCHED;
            PG8_LDB(B0, 1, 0); PG8_LDB(B1, 1, 1); PG8_SCHED; PG8_LDA(At, 1, 0); PG8_STAGE(PG8_SA(0, 1), a2 + hsA, voffA);
            PG8_WAIT_V(8); PG8_WAIT_L(0); PG8_BAR; PG8_MMA(0, 0, At, B0); PG8_MMA(0, 1, At, B1); PG8_BAR; PG8_SCHED;
            PG8_LDA(At, 1, 1); PG8_STAGE(PG8_SB(1, 0), b3, voffB); PG8_STAGE(PG8_SB(1, 1), b3 + hsB, voffB); PG8_STAGE(PG8_SA(1, 0), a3, voffA);
            PG8_WAIT_V(8); PG8_WAIT_L(0); PG8_BAR; PG8_MMA(1, 0, At, B0); PG8_MMA(1, 1, At, B1); PG8_BAR; PG8_SCHED;
        }
        if constexpr (ALIGN_EPI) { if (wr == 0) PG8_BAR; }
        E(acc, cur, wr, wc, fr, fq);
        if (!has_next) break;
#pragma unroll
        for (int a = 0; a < 2; ++a)
#pragma unroll
            for (int b = 0; b < 2; ++b)
#pragma unroll
                for (int m = 0; m < 4; ++m)
#pragma unroll
                    for (int n = 0; n < 2; ++n) acc[a][b][m][n] = (f32x4){0.f, 0.f, 0.f, 0.f};
        cur = nxt; cA = nA; cB = nB; ++ui;
        if constexpr (ALIGN_EPI) { if (wr == 1) PG8_BAR; }
    }
    PG8_WAIT_V(0);
    if constexpr (!ALIGN_EPI) { if (wr == 0) PG8_BAR; }
    PG8_BAR;
#undef PG8_SA
#undef PG8_SB
#undef PG8_STAGE
#undef PG8_LDA
#undef PG8_LDB
#undef PG8_MMA
#undef PG8_WAIT_V
#undef PG8_WAIT_L
#undef PG8_BAR
#undef PG8_SCHED
}
__host__ __device__ __forceinline__ int sw8(int r) { return ((r >> 1) & 1) | (((r >> 3) & 1) << 2); }
template <class Epi, class Sched, bool ALIGN_EPI = true>
__device__ __forceinline__ void gemm_phase_f8(LAS unsigned char* lds, const Gemm g, const Sched& S, const Epi& E) {
    const int tid = threadIdx.x, wid = __builtin_amdgcn_readfirstlane(tid >> 6), lane = tid & 63, wr = wid >> 2, wc = wid & 3, fr = lane & 15, fq = lane >> 4;
    const int K = g.K, nt = K / 128;
    unsigned voffA[2], voffB[2];
#pragma unroll
    for (int i = 0; i < 2; ++i) { const int bb = tid * 16 + i * 8192, R = (bb >> 11) * 16 + ((bb >> 7) & 15), ch = ((bb >> 4) & 7) ^ sw8(R & 15); const int Rb = Epi::PERM ? ((R & ~31) + perm32(R & 31)) : R;
        voffA[i] = (unsigned)(R * g.lda + ch * 16); voffB[i] = (unsigned)(Rb * g.ldb + ch * 16); }
    const size_t kstep = (size_t)(BK * 2);
    const size_t hsA = (size_t)HALF * g.lda, hsB = (size_t)HALF * g.ldb;
    const unsigned ldsw = (unsigned)wid * 1024u;
    const int scl = 0x7f7f7f7f;
    const int aoff = (wr * 4) * 2048 + fr * 128, boff = (wc * 2) * 2048 + fr * 128, c0off = ((2 * fq) ^ sw8(fr)) * 16, c1off = ((2 * fq + 1) ^ sw8(fr)) * 16;
#define PG8_SA(b, h) (((b) * 2 + (h)) * HTB)
#define PG8_SB(b, h) ((4 + (b) * 2 + (h)) * HTB)
#define PG8_STAGE(bufoff, gbase, voff) do { _Pragma("unroll") for (int _i = 0; _i < 2; ++_i) \
        __builtin_amdgcn_global_load_lds((const unsigned*)((const char*)(gbase) + (voff)[_i]), (LAS unsigned*)(lds + (bufoff) + ldsw + _i * 8192), 16, 0, 0); } while (0)
#define PG8_LDA(dst, b, h) do { _Pragma("unroll") for (int m = 0; m < 4; ++m) { dst[m][0] = *(const LAS bf16x8*)(lds + PG8_SA(b, h) + aoff + m * 2048 + c0off); dst[m][1] = *(const LAS bf16x8*)(lds + PG8_SA(b, h) + aoff + m * 2048 + c1off); } } while (0)
#define PG8_LDB(dst, b, h) do { _Pragma("unroll") for (int n = 0; n < 2; ++n) { dst[n][0] = *(const LAS bf16x8*)(lds + PG8_SB(b, h) + boff + n * 2048 + c0off); dst[n][1] = *(const LAS bf16x8*)(lds + PG8_SB(b, h) + boff + n * 2048 + c1off); } } while (0)
#define PG8_F8(x) __builtin_shufflevector(__builtin_bit_cast(i32x4, x[0]), __builtin_bit_cast(i32x4, x[1]), 0, 1, 2, 3, 4, 5, 6, 7)
#define PG8_MMA(ai, bj, At, Bt) do { __builtin_amdgcn_s_setprio(1); _Pragma("unroll") for (int m = 0; m < 4; ++m) _Pragma("unroll") for (int n = 0; n < 2; ++n) \
        asm volatile("v_mfma_f32_16x16x128_f8f6f4 %0, %1, %2, %0" : "+v"(acc[ai][bj][m][n]) : "v"(PG8_F8(Bt[n])), "v"(PG8_F8(At[m]))); __builtin_amdgcn_s_setprio(0); } while (0)
#define PG8_WAIT_V(n) asm volatile("s_waitcnt vmcnt(" #n ")" ::: "memory")
#define PG8_WAIT_L(n) asm volatile("s_waitcnt lgkmcnt(" #n ")" ::: "memory")
#define PG8_BAR __builtin_amdgcn_s_barrier()
#define PG8_SCHED __builtin_amdgcn_sched_barrier(0)
    Unit cur, nxt; int ui = 0;
    if (!S.next(0, cur)) return;
    f32x4 acc[2][2][4][2];
#pragma unroll
    for (int a = 0; a < 2; ++a)
#pragma unroll
        for (int b = 0; b < 2; ++b)
#pragma unroll
            for (int m = 0; m < 4; ++m)
#pragma unroll
                for (int n = 0; n < 2; ++n) acc[a][b][m][n] = (f32x4){0.f, 0.f, 0.f, 0.f};
    bf16x8 At[4][2], B0[2][2], B1[2][2];
    const char* cA = S.pa(cur); const char* cB = S.pb(cur);
    PG8_STAGE(PG8_SB(0, 0), cB, voffB); PG8_STAGE(PG8_SB(0, 1), cB + hsB, voffB); PG8_STAGE(PG8_SA(0, 0), cA, voffA); PG8_STAGE(PG8_SA(0, 1), cA + hsA, voffA);
    if (wr == 1) PG8_BAR;
    PG8_WAIT_V(2); PG8_BAR;
    PG8_STAGE(PG8_SB(1, 0), cB + kstep, voffB); PG8_STAGE(PG8_SA(1, 0), cA + kstep, voffA); PG8_STAGE(PG8_SB(1, 1), cB + hsB + kstep, voffB);
    PG8_WAIT_V(6); PG8_BAR;
    for (;;) {
        const bool has_next = S.next(ui + 1, nxt);
        const char* nA = has_next ? S.pa(nxt) : cA; const char* nB = has_next ? S.pb(nxt) : cB;
        const int ntu = S.nt(cur, nt);
        for (int t = 0; t < ntu; t += 2) {
            const bool last = (t == ntu - 2);
            const char* a1 = cA + (size_t)(t + 1) * kstep;
            const char* a2 = last ? nA : cA + (size_t)(t + 2) * kstep; const char* b2 = last ? nB : cB + (size_t)(t + 2) * kstep;
            const char* a3 = a2 + kstep; const char* b3 = b2 + kstep;
            PG8_LDB(B0, 0, 0); PG8_LDB(B1, 0, 1); PG8_SCHED; PG8_LDA(At, 0, 0); PG8_STAGE(PG8_SA(1, 1), a1 + hsA, voffA);
            PG8_WAIT_V(8); PG8_WAIT_L(0); PG8_BAR; PG8_MMA(0, 0, At, B0); PG8_MMA(0, 1, At, B1); PG8_BAR; PG8_SCHED;
            PG8_LDA(At, 0, 1); PG8_STAGE(PG8_SB(0, 0), b2, voffB); PG8_STAGE(PG8_SB(0, 1), b2 + hsB, voffB); PG8_STAGE(PG8_SA(0, 0), a2, voffA);
            PG8_WAIT_V(8); PG8_WAIT_L(0); PG8_BAR; PG8_MMA(1, 0, At, B0); PG8_MMA(1, 1, At, B1); PG8_BAR; PG8_SCHED;
            PG8_LDB(B0, 1, 0); PG8_LDB(B1, 1, 1); PG8_SCHED; PG8_LDA(At, 1, 0); PG8_STAGE(PG8_SA(0, 1), a2 + hsA, voffA);
            PG8_WAIT_V(8); PG8_WAIT_L(0); PG8_BAR; PG8_MMA(0, 0, At, B0); PG8_MMA(0, 1, At, B1); PG8_BAR; PG8_SCHED;
            PG8_LDA(At, 1, 1); PG8_STAGE(PG8_SB(1, 0), b3, voffB); PG8_STAGE(PG8_SB(1, 1), b3 + hsB, voffB); PG8_STAGE(PG8_SA(1, 0), a3, voffA);
            PG8_WAIT_V(8); PG8_WAIT_L(0); PG8_BAR; PG8_MMA(1, 0, At, B0); PG8_MMA(1, 1, At, B1); PG8_BAR; PG8_SCHED;
        }
        if constexpr (ALIGN_EPI) { if (wr == 0) PG8_BAR; }
        E(acc, cur, wr, wc, fr, fq);
        if (!has_next) break;
#pragma unroll
        for (int a = 0; a < 2; ++a)
#pragma unroll
            for (int b = 0; b < 2; ++b)
#pragma unroll
                for (int m = 0; m < 4; ++m)
#pragma unroll
                    for (int n = 0; n < 2; ++n) acc[a][b][m][n] = (f32x4){0.f, 0.f, 0.f, 0.f};
        cur = nxt; cA = nA; cB = nB; ++ui;
        if constexpr (ALIGN_EPI) { if (wr == 1) PG8_BAR; }
    }
    PG8_WAIT_V(0);
    if constexpr (!ALIGN_EPI) { if (wr == 0) PG8_BAR; }
    PG8_BAR;
#undef PG8_SA
#undef PG8_SB
#undef PG8_STAGE
#undef PG8_LDA
#undef PG8_LDB
#undef PG8_MMA
#undef PG8_F8
#undef PG8_WAIT_V
#undef PG8_WAIT_L
#undef PG8_BAR
#undef PG8_SCHED
}
}
using pg8::Unit;

typedef const f32x4 (&AccRef)[2][2][4][2];

__device__ __forceinline__ void store_bf16x8(bf16_t* p, f32x4 v0, f32x4 v1) {
    u32x4 w; w.x = cvt_pk_bf16(v0[0], v0[1]); w.y = cvt_pk_bf16(v0[2], v0[3]); w.z = cvt_pk_bf16(v1[0], v1[1]); w.w = cvt_pk_bf16(v1[2], v1[3]);
    *(u32x4*)p = w;
}

struct EpiProj {
    static constexpr bool PERM = true;
    const float* rs; bf16_t* sbq; bf16_t* dq; bf16_t* dkv; bf16_t* memq; bf16_t* gates; float* ssq_dq; float* ssq_dkv; int pn0; float gsc;
    __device__ __forceinline__ void operator()(AccRef acc, const Unit& u, int wr, int wc, int fr, int fq) const {
        const int pn = u.pn + pn0, row0 = u.pm * 256 + wr * 64 + fr, cl = wc * 32 + 8 * fq;
        bf16_t* base; int ldc; float cs = 1.f; int mode = 0; float* sq = nullptr; int ns = 0, slot = 0;
        if (pn < 24) { const int which = pn >> 3; base = sbq + (size_t)which * ((size_t)T * 2048) + (pn & 7) * 256; ldc = 2048; if (which == 0) cs = C_SB; }
        else if (pn < 28) { base = dq + (pn - 24) * 256; ldc = 1024; sq = ssq_dq; ns = 16; slot = (pn - 24) * 4 + wc; }
        else if (pn < 31) { base = dkv + (pn - 28) * 256; ldc = 768; if (pn < 30) { sq = ssq_dkv; ns = 8; slot = (pn - 28) * 4 + wc; } }
        else if (pn < 39) { base = memq + (pn - 31) * 256; ldc = 2048; cs = C_MEM * gsc; }
        else { base = gates + ((size_t)(u.pm * 48 + (pn - 39)) << 16); ldc = 0; mode = 1; cs = gsc; }
        const int bjs = mode == 1 ? 512 : 128;
        float rsv[8];
#pragma unroll
        for (int q = 0; q < 8; ++q) rsv[q] = rs[row0 + (q >> 2) * 128 + (q & 3) * 16];
#pragma unroll
        for (int ai = 0; ai < 2; ++ai)
#pragma unroll
            for (int m = 0; m < 4; ++m) {
                const int row = row0 + ai * 128 + m * 16; const float sc = rsv[ai * 4 + m] * cs; float s2 = 0.f;
                bf16_t* rowp = mode == 1 ? base + (size_t)(((((wr * 4 + wc) * 2 + ai) * 4 + m) * 2) * 64 + fq * 16 + fr) * 8 : base + (size_t)row * ldc + cl;
#pragma unroll
                for (int bj = 0; bj < 2; ++bj) {
                    f32x4 v0 = acc[ai][bj][m][0] * sc, v1 = acc[ai][bj][m][1] * sc;
                    if (mode == 1) {
#pragma unroll
                        for (int j = 0; j < 4; ++j) { v0[j] = frcp(1.f + fexp2(-LOG2E * v0[j])); v1[j] = frcp(1.f + fexp2(-LOG2E * v1[j])); }
                    }

                    s2 += (v0[0] * v0[0] + v0[1] * v0[1]) + (v0[2] * v0[2] + v0[3] * v0[3]) + (v1[0] * v1[0] + v1[1] * v1[1]) + (v1[2] * v1[2] + v1[3] * v1[3]);
                    store_bf16x8(rowp + bj * bjs, v0, v1);
                }
                if (sq) { s2 += __shfl_xor(s2, 16); s2 += __shfl_xor(s2, 32); if (fq == 0) sq[(size_t)row * ns + slot] = s2; }
            }
    }
};
struct EpiMemKV {
    static constexpr bool PERM = false;
    bf16_t* mk; bf16_t* mvt;
    __device__ __forceinline__ void operator()(AccRef acc, const Unit& u, int wr, int wc, int fr, int fq) const {
        const int row0 = u.pm * 256 + wr * 64 + fr;
#pragma unroll
        for (int ai = 0; ai < 2; ++ai)
#pragma unroll
            for (int m = 0; m < 4; ++m) {
                const int row = row0 + ai * 128 + m * 16;
#pragma unroll
                for (int bj = 0; bj < 2; ++bj)
#pragma unroll
                    for (int n = 0; n < 2; ++n) {
                        const int col = u.pn * 256 + bj * 128 + wc * 32 + n * 16 + 4 * fq; const f32x4 v = acc[ai][bj][m][n];
                        if (u.pn < 8) { u32x2 w; w.x = cvt_pk_bf16(v[0], v[1]); w.y = cvt_pk_bf16(v[2], v[3]); *(u32x2*)(mk + (size_t)row * 2048 + col) = w; }
                        else { int q8 = __builtin_amdgcn_cvt_pk_fp8_f32(__builtin_amdgcn_fmed3f(v[0] * MV_SC, -448.f, 448.f), __builtin_amdgcn_fmed3f(v[1] * MV_SC, -448.f, 448.f), 0, false);
                            q8 = __builtin_amdgcn_cvt_pk_fp8_f32(__builtin_amdgcn_fmed3f(v[2] * MV_SC, -448.f, 448.f), __builtin_amdgcn_fmed3f(v[3] * MV_SC, -448.f, 448.f), q8, true);
                            *(unsigned*)((unsigned char*)mvt + (size_t)row * 2048 + (col - 2048)) = (unsigned)q8; }
                    }
            }
    }
};
template <int NS> __device__ __forceinline__ float slot_sum(const float* p) {
    float s = 0.f;
#pragma unroll
    for (int i = 0; i < NS / 4; ++i) { const f32x4 v = ((const f32x4*)p)[i]; s += (v[0] + v[1]) + (v[2] + v[3]); }
    return s;
}
struct EpiUQ {
    static constexpr bool PERM = true;
    const float* ssq; const f32x2* cs; bf16_t* q;
    __device__ __forceinline__ void operator()(AccRef acc, const Unit& u, int wr, int wc, int fr, int fq) const {
        const int row0 = u.pm * 256 + wr * 64 + fr;
#pragma unroll
        for (int ai = 0; ai < 2; ++ai) {
            float scv[4];
#pragma unroll
            for (int q = 0; q < 4; ++q) scv[q] = __builtin_amdgcn_rsqf(slot_sum<16>(ssq + (size_t)(row0 + ai * 128 + q * 16) * 16) * (1.f / 1024.f) + EPS) * C_MLA;
#pragma unroll
            for (int m = 0; m < 4; ++m) {
                const int row = row0 + ai * 128 + m * 16; const float sc = scv[m];
#pragma unroll
                for (int bj = 0; bj < 2; ++bj) {
                    const int col = u.pn * 256 + bj * 128 + wc * 32 + 8 * fq; const int d = col % 192;
                    f32x4 v0 = acc[ai][bj][m][0] * sc, v1 = acc[ai][bj][m][1] * sc;
                    if (d >= 128) {
                        const f32x2* c = cs + (size_t)row * 32 + ((d - 128) >> 1);
                        const f32x2 c0 = c[0], c1 = c[1], c2 = c[2], c3 = c[3];
                        f32x4 o0, o1;
                        o0[0] = v0[0] * c0.x - v0[1] * c0.y; o0[1] = v0[0] * c0.y + v0[1] * c0.x;
                        o0[2] = v0[2] * c1.x - v0[3] * c1.y; o0[3] = v0[2] * c1.y + v0[3] * c1.x;
                        o1[0] = v1[0] * c2.x - v1[1] * c2.y; o1[1] = v1[0] * c2.y + v1[1] * c2.x;
                        o1[2] = v1[2] * c3.x - v1[3] * c3.y; o1[3] = v1[2] * c3.y + v1[3] * c3.x;
                        v0 = o0; v1 = o1;
                    }
                    store_bf16x8(q + (size_t)row * 3072 + col, v0, v1);
                }
            }
        }
    }
};
struct EpiUKV {
    static constexpr bool PERM = true;
    const float* ssq; bf16_t* kn; bf16_t* vv;
    __device__ __forceinline__ void operator()(AccRef acc, const Unit& u, int wr, int wc, int fr, int fq) const {
        const int row0 = u.pm * 256 + wr * 64 + fr, cl = u.pn * 128 + wc * 32 + 8 * fq;
        float scv[8];
#pragma unroll
        for (int q = 0; q < 8; ++q) scv[q] = __builtin_amdgcn_rsqf(slot_sum<8>(ssq + (size_t)(row0 + (q >> 2) * 128 + (q & 3) * 16) * 8) * (1.f / 512.f) + EPS);
#pragma unroll
        for (int ai = 0; ai < 2; ++ai)
#pragma unroll
            for (int m = 0; m < 4; ++m) {
                const int row = row0 + ai * 128 + m * 16; const float sc = scv[ai * 4 + m];
                store_bf16x8(kn + (size_t)row * 3072 + u.pn * 192 + wc * 32 + 8 * fq, acc[ai][0][m][0] * sc, acc[ai][0][m][1] * sc);
                store_bf16x8(vv + (size_t)row * 2048 + cl, acc[ai][1][m][0] * sc, acc[ai][1][m][1] * sc);
            }
    }
};
struct EpiMemS {
    static constexpr bool PERM = false;
    float* s;
    __device__ __forceinline__ void operator()(AccRef acc, const Unit& u, int wr, int wc, int fr, int fq) const {
        const int b = u.z >> 2, h = u.z & 3, row0 = b * SEQ + u.pm * 256 + wr * 64 + fr;
#pragma unroll
        for (int ai = 0; ai < 2; ++ai)
#pragma unroll
            for (int m = 0; m < 4; ++m) { float* rowp = s + ((size_t)(row0 + ai * 128 + m * 16) * 4 + h) * 256 + wc * 32 + 4 * fq;
#pragma unroll
                for (int bj = 0; bj < 2; ++bj)
#pragma unroll
                    for (int n = 0; n < 2; ++n) *(f32x4*)(rowp + bj * 128 + n * 16) = acc[ai][bj][m][n]; }
    }
};
struct EpiVW {
    static constexpr bool PERM = false;
    unsigned char* bt;
    __device__ __forceinline__ void operator()(AccRef acc, const Unit& u, int wr, int wc, int fr, int fq) const {
        const int b = u.z >> 2, h = u.z & 3, row0 = u.pm * 256 + wr * 64 + fr;
        const float sc = BT_SC / (WBR_SC * MV_SC);
#pragma unroll
        for (int ai = 0; ai < 2; ++ai)
#pragma unroll
            for (int m = 0; m < 4; ++m) { unsigned char* rowp = bt + (size_t)b * ((size_t)4096 * 2048) + (size_t)(row0 + ai * 128 + m * 16) * 2048 + h * 256 + wc * 32 + 4 * fq;
#pragma unroll
                for (int bj = 0; bj < 2; ++bj)
#pragma unroll
                    for (int n = 0; n < 2; ++n) { const f32x4 v = acc[ai][bj][m][n] * sc;
                        int q8 = __builtin_amdgcn_cvt_pk_fp8_f32(__builtin_amdgcn_fmed3f(v[0], -448.f, 448.f), __builtin_amdgcn_fmed3f(v[1], -448.f, 448.f), 0, false);
                        q8 = __builtin_amdgcn_cvt_pk_fp8_f32(__builtin_amdgcn_fmed3f(v[2], -448.f, 448.f), __builtin_amdgcn_fmed3f(v[3], -448.f, 448.f), q8, true);
                        *(unsigned*)(rowp + bj * 128 + n * 16) = (unsigned)q8; } }
    }
};
struct EpiMemPV {
    static constexpr bool PERM = true;
    unsigned char* y;
    __device__ __forceinline__ void operator()(AccRef acc, const Unit& u, int wr, int wc, int fr, int fq) const {
        const int b = u.z >> 2, h = u.z & 3, row0 = b * SEQ + u.pm * 256 + wr * 64 + fr, cl = h * 512 + u.pn * 256 + wc * 32 + 8 * fq;
#pragma unroll
        for (int ai = 0; ai < 2; ++ai)
#pragma unroll
            for (int m = 0; m < 4; ++m) { unsigned char* rowp = y + (size_t)(row0 + ai * 128 + m * 16) * 2048 + cl;
#pragma unroll
                for (int bj = 0; bj < 2; ++bj) { const f32x4 v0 = acc[ai][bj][m][0] * YC_SC, v1 = acc[ai][bj][m][1] * YC_SC;
                    int w0 = __builtin_amdgcn_cvt_pk_fp8_f32(v0[0], v0[1], 0, false); w0 = __builtin_amdgcn_cvt_pk_fp8_f32(v0[2], v0[3], w0, true);
                    int w1 = __builtin_amdgcn_cvt_pk_fp8_f32(v1[0], v1[1], 0, false); w1 = __builtin_amdgcn_cvt_pk_fp8_f32(v1[2], v1[3], w1, true);
                    *(u32x2*)(rowp + bj * 128) = (u32x2){(unsigned)w0, (unsigned)w1}; } }
    }
};
struct EpiMerge {
    static constexpr bool PERM = true;
    const bf16_t* gates; bf16_t* merged; unsigned char* mg8;
    __device__ __forceinline__ void operator()(AccRef acc, const Unit& u, int wr, int wc, int fr, int fq) const {
        const int row0 = u.pm * 256 + wr * 64 + fr, cl = u.pn * 256 + wc * 32 + 8 * fq;
        const float bsc = u.z == 0 ? 1.f / WBR_SC : (u.z == 1 ? 1.f / (YB_SC * WBR_SC) : 1.f / (P8_SC * BT_SC));
        const bf16_t* gtile = gates + ((size_t)(u.pm * 48 + u.z * 16 + u.pn) << 16); bf16_t* mtile = merged + ((size_t)(u.pm * 16 + u.pn) << 16);
        int lidx = ((wr * 4 + wc) * 16) * 64 + fq * 16 + fr;
        asm volatile("" : "+v"(lidx));
#pragma unroll
        for (int ai = 0; ai < 2; ++ai) {
            u32x4 gw[8], pw[8];
#pragma unroll
            for (int q = 0; q < 8; ++q) { const int row = row0 + ai * 128 + (q >> 1) * 16, bj = q & 1;
                const int pos = (lidx + ((ai * 4 + (q >> 1)) * 2 + bj) * 64) * 8; (void)row;
                gw[q] = *(const u32x4*)(gtile + pos);
                pw[q] = u.z > 0 ? *(const u32x4*)(mtile + pos) : (u32x4){0u, 0u, 0u, 0u}; }
#pragma unroll
            for (int q = 0; q < 8; ++q) { const int m = q >> 1, bj = q & 1, row = row0 + ai * 128 + m * 16;
                f32x4 v0 = acc[ai][bj][m][0] * bsc, v1 = acc[ai][bj][m][1] * bsc;
                v0[0] = fmaf(v0[0], bf_lo(gw[q].x), bf_lo(pw[q].x)); v0[1] = fmaf(v0[1], bf_hi(gw[q].x), bf_hi(pw[q].x)); v0[2] = fmaf(v0[2], bf_lo(gw[q].y), bf_lo(pw[q].y)); v0[3] = fmaf(v0[3], bf_hi(gw[q].y), bf_hi(pw[q].y));
                v1[0] = fmaf(v1[0], bf_lo(gw[q].z), bf_lo(pw[q].z)); v1[1] = fmaf(v1[1], bf_hi(gw[q].z), bf_hi(pw[q].z)); v1[2] = fmaf(v1[2], bf_lo(gw[q].w), bf_lo(pw[q].w)); v1[3] = fmaf(v1[3], bf_hi(gw[q].w), bf_hi(pw[q].w));
                if (u.z < 2) store_bf16x8(mtile + (lidx + ((ai * 4 + m) * 2 + bj) * 64) * 8, v0, v1);
                else { int w0 = __builtin_amdgcn_cvt_pk_fp8_f32(v0[0] * MG_SC, v0[1] * MG_SC, 0, false); w0 = __builtin_amdgcn_cvt_pk_fp8_f32(v0[2] * MG_SC, v0[3] * MG_SC, w0, true);
                    int w1 = __builtin_amdgcn_cvt_pk_fp8_f32(v1[0] * MG_SC, v1[1] * MG_SC, 0, false); w1 = __builtin_amdgcn_cvt_pk_fp8_f32(v1[2] * MG_SC, v1[3] * MG_SC, w1, true);
                    *(u32x2*)(mg8 + (size_t)row * 4096 + cl + bj * 128) = (u32x2){(unsigned)w0, (unsigned)w1}; } }
        }
    }
};
struct EpiOut {
    static constexpr bool PERM = false;
    const float* x; float* h1; bf16_t* h1b; float* ssq; float osc;
    __device__ __forceinline__ void operator()(AccRef acc, const Unit& u, int wr, int wc, int fr, int fq) const {
        const int row0 = u.pm * 256 + wr * 64 + fr, cl = u.pn * 256 + wc * 32 + 4 * fq;
#pragma unroll
        for (int ai = 0; ai < 2; ++ai) {
            f32x4 xv[16];
#pragma unroll
            for (int q = 0; q < 16; ++q) xv[q] = *(const f32x4*)(x + (size_t)(row0 + ai * 128 + (q >> 2) * 16) * D + cl + ((q >> 1) & 1) * 128 + (q & 1) * 16);
#pragma unroll
            for (int m = 0; m < 4; ++m) {
                const int row = row0 + ai * 128 + m * 16; float s2 = 0.f;
#pragma unroll
                for (int bj = 0; bj < 2; ++bj)
#pragma unroll
                    for (int n = 0; n < 2; ++n) {
                        const size_t o = (size_t)row * D + cl + bj * 128 + n * 16;
                        const f32x4 v = acc[ai][bj][m][n] * osc + xv[m * 4 + bj * 2 + n];
                        u32x2 w; w.x = cvt_pk_bf16(v[0], v[1]); w.y = cvt_pk_bf16(v[2], v[3]); *(u32x2*)(h1b + o) = w;
                        s2 += (v[0] * v[0] + v[1] * v[1]) + (v[2] * v[2] + v[3] * v[3]);
                    }
                s2 += __shfl_xor(s2, 16); s2 += __shfl_xor(s2, 32); if (fq == 0) ssq[(size_t)row * 64 + u.pn * 4 + wc] = s2;
            }
        }
    }
};
struct EpiPQ {
    static constexpr bool PERM = true;
    const float* ssq; bf16_t* pq;
    __device__ __forceinline__ void operator()(AccRef acc, const Unit& u, int wr, int wc, int fr, int fq) const {
        const int row0 = u.pm * 256 + wr * 64 + fr, cl = u.pn * 256 + wc * 32 + 8 * fq;
        float scv[8];
#pragma unroll
        for (int q = 0; q < 8; ++q) scv[q] = __builtin_amdgcn_rsqf(slot_sum<64>(ssq + (size_t)(row0 + (q >> 2) * 128 + (q & 3) * 16) * 64) * (1.f / 4096.f) + EPS);
#pragma unroll
        for (int ai = 0; ai < 2; ++ai)
#pragma unroll
            for (int m = 0; m < 4; ++m) {
                const int row = row0 + ai * 128 + m * 16;
                const float sc = scv[ai * 4 + m];
#pragma unroll
                for (int bj = 0; bj < 2; ++bj) store_bf16x8(pq + (size_t)row * 2048 + cl + bj * 128, acc[ai][bj][m][0] * sc, acc[ai][bj][m][1] * sc);
            }
    }
};

#define XB_TMO      128
#define XB_XCNT(j)  (256  + 64 * (j))
#define XB_XSUB(j)  (1280 + 64 * (j))
#define XB_XGEN(j)  (2304 + 64 * (j))
#define XB_TOP      3328
#define XB_TOPGEN   3392
#define XCD_BAR_WORDS 3456
#define XB_SPIN_CAP (1u << 20)
__device__ __forceinline__ unsigned xb_ld(unsigned* p)              { return __hip_atomic_load(p, __ATOMIC_RELAXED, __HIP_MEMORY_SCOPE_AGENT); }
__device__ __forceinline__ unsigned xb_add(unsigned* p, unsigned v) { return __hip_atomic_fetch_add(p, v, __ATOMIC_RELAXED, __HIP_MEMORY_SCOPE_AGENT); }
__device__ __forceinline__ unsigned xb_xcc_id() { return (unsigned)__builtin_amdgcn_s_getreg((3 << 11) | 20) & 0xFu; }
#define XB_SPIN(cond, bar) do { unsigned _sp = 0; while (cond) { __builtin_amdgcn_s_sleep(1); \
    if ((++_sp & 255u) == 0u) { if (xb_ld(&(bar)[XB_TMO])) break; if (_sp > XB_SPIN_CAP) { atomicAdd(&(bar)[XB_TMO], 1u); break; } } } } while (0)
struct XcdBarrier { unsigned* bar; unsigned x; volatile LAS unsigned* st; };
__device__ __forceinline__ XcdBarrier xcd_barrier_post(unsigned* bar, volatile LAS unsigned* st) {
    XcdBarrier b; b.bar = bar; b.x = xb_xcc_id(); b.st = st;
    if (threadIdx.x == 0) (void)xb_add(&bar[XB_XCNT(b.x)], 1u);
    return b;
}
__device__ __forceinline__ void xcd_barrier_complete(unsigned* bar, unsigned x, unsigned& nloc, unsigned& nx) {
    const unsigned G = gridDim.x * gridDim.y * gridDim.z;
    unsigned sum, cnt, mine, sp = 0u;
    for (;;) {
        sum = 0u; cnt = 0u; mine = 0u;
#pragma unroll
        for (unsigned j = 0; j < 16; ++j) { const unsigned c = xb_ld(&bar[XB_XCNT(j)]); sum += c; cnt += (c > 0u) ? 1u : 0u; mine = (j == x) ? c : mine; }
        if (sum == G) break;
        __builtin_amdgcn_s_sleep(1);
        if ((++sp & 255u) == 0u) { if (xb_ld(&bar[XB_TMO])) break; if (sp > XB_SPIN_CAP) { atomicAdd(&bar[XB_TMO], 1u); break; } }
    }
    nloc = mine > 0u ? mine : 1u; nx = cnt > 0u ? cnt : 1u;
}
__device__ __forceinline__ void xcd_barrier(const XcdBarrier& b) {
    asm volatile("s_waitcnt vmcnt(0)" ::: "memory");
    __syncthreads();
    if (threadIdx.x == 0) {
        unsigned* bar = b.bar;
        __builtin_amdgcn_s_waitcnt(0);
        unsigned nloc = b.st[0], nx = b.st[1];
        if (nloc == 0u) { xcd_barrier_complete(bar, b.x, nloc, nx); b.st[0] = nloc; b.st[1] = nx; }
        const unsigned old = xb_add(&bar[XB_XSUB(b.x)], 1u);
        const unsigned gen = old / nloc;
        if (old + 1u == (gen + 1u) * nloc) {
            __builtin_amdgcn_fence(__ATOMIC_RELEASE, "agent");
            asm volatile("s_waitcnt vmcnt(0)" ::: "memory");
            const unsigned og = xb_add(&bar[XB_TOP], 1u);
            const unsigned tg = og / nx;
            if (og + 1u == (tg + 1u) * nx) xb_add(&bar[XB_TOPGEN], 1u);
            else XB_SPIN(xb_ld(&bar[XB_TOPGEN]) == tg, bar);
            __builtin_amdgcn_fence(__ATOMIC_ACQUIRE, "agent");
            xb_add(&bar[XB_XGEN(b.x)], 1u);
            asm volatile("s_waitcnt vmcnt(0)" ::: "memory");
        } else {
            XB_SPIN(xb_ld(&bar[XB_XGEN(b.x)]) == gen, bar);
            __builtin_amdgcn_fence(__ATOMIC_ACQUIRE, "agent");
            asm volatile("s_waitcnt vmcnt(0)" ::: "memory");
        }
    }
    __syncthreads();
}

template <class Map, bool F8 = false>
__device__ __forceinline__ void tr_item(const float* W, int K, int Nsrc, bf16_t* WT, const float* gain, LAS float* scr, int item, int nblk, int lane, Map map, float osc = 1.f) {
    const int kb = item / nblk, nb = item % nblk, k0 = 64 * kb, j0 = 32 * nb;
    if (Map::CONTIG) {
        const int sc0 = map(j0);
        f32x4 v[8];
#pragma unroll
        for (int q = 0; q < 8; ++q) { const int idx = q * 64 + lane, row = idx >> 3, c4 = idx & 7;
            v[q] = sc0 >= 0 ? *(const f32x4*)(W + (size_t)(k0 + row) * Nsrc + sc0 + c4 * 4) : (f32x4){0.f, 0.f, 0.f, 0.f}; }
#pragma unroll
        for (int q = 0; q < 8; ++q) { const int idx = q * 64 + lane, row = idx >> 3, c4 = idx & 7; f32x4 w = v[q]; if (gain) w = w * gain[k0 + row];
            LAS float* d = scr + row * 33 + c4 * 4; d[0] = w[0]; d[1] = w[1]; d[2] = w[2]; d[3] = w[3]; }
    } else {
        const int sc = map(j0 + (lane & 31));
#pragma unroll 8
        for (int i = 0; i < 32; ++i) { const int kk = 2 * i + (lane >> 5); float v = sc >= 0 ? W[(size_t)(k0 + kk) * Nsrc + sc] : 0.f; if (gain) v *= gain[k0 + kk]; scr[kk * 33 + (lane & 31)] = v; }
    }
    LDS_WAIT(); asm volatile("" ::: "memory");
    const int c = lane & 7;
#pragma unroll
    for (int j = 0; j < 4; ++j) { const int n = (lane >> 3) + 8 * j; const LAS float* s = scr + (8 * c) * 33 + n;
        if (F8) { int w0 = __builtin_amdgcn_cvt_pk_fp8_f32(s[0 * 33] * osc, s[1 * 33] * osc, 0, false); w0 = __builtin_amdgcn_cvt_pk_fp8_f32(s[2 * 33] * osc, s[3 * 33] * osc, w0, true);
            int w1 = __builtin_amdgcn_cvt_pk_fp8_f32(s[4 * 33] * osc, s[5 * 33] * osc, 0, false); w1 = __builtin_amdgcn_cvt_pk_fp8_f32(s[6 * 33] * osc, s[7 * 33] * osc, w1, true);
            *(u32x2*)((unsigned char*)WT + (size_t)(j0 + n) * K + k0 + 8 * c) = (u32x2){(unsigned)w0, (unsigned)w1}; }
        else { u32x4 o; o.x = cvt_pk_bf16(s[0 * 33], s[1 * 33]); o.y = cvt_pk_bf16(s[2 * 33], s[3 * 33]); o.z = cvt_pk_bf16(s[4 * 33], s[5 * 33]); o.w = cvt_pk_bf16(s[6 * 33], s[7 * 33]);
            *(u32x4*)(WT + (size_t)(j0 + n) * K + k0 + 8 * c) = o; } }
    LDS_WAIT(); asm volatile("" ::: "memory");
}
struct MapId { static constexpr bool CONTIG = true; __device__ __forceinline__ int operator()(int j) const { return j; } };
struct MapWin { static constexpr bool CONTIG = true; __device__ __forceinline__ int operator()(int j) const { return j < 7744 ? j : (j < 7936 ? -1 : j - 192); } };
struct MapGate { static constexpr bool CONTIG = true; __device__ __forceinline__ int operator()(int j) const { return 7744 + j; } };
struct MapUq { static constexpr bool CONTIG = false; __device__ __forceinline__ int operator()(int j) const { const int h = j / 192, d = j % 192; if (d < 128) return j; const int e = d - 128; return h * 192 + 128 + (e & 1) * 32 + (e >> 1); } };

__device__ __forceinline__ float row_to_bf16(const float* xrow, bf16_t* orow, const float* gain, int lane, unsigned* o8 = nullptr) {
    const f32x4* xr = (const f32x4*)xrow + lane;
    f32x4 v[16]; float s = 0.f;
#pragma unroll
    for (int j = 0; j < 16; ++j) { v[j] = xr[64 * j]; s += (v[j][0] * v[j][0] + v[j][1] * v[j][1]) + (v[j][2] * v[j][2] + v[j][3] * v[j][3]); }
    const float rs = __builtin_amdgcn_rsqf(wave_sum(s) * (1.f / 4096.f) + EPS);
    u32x2* o8b = (u32x2*)orow + lane;
#pragma unroll
    for (int j = 0; j < 16; ++j) {
        f32x4 w = v[j];
        if (gain) { const f32x4 g = ((const f32x4*)gain)[64 * j + lane]; w = w * rs * g; }
        u32x2 p; p.x = cvt_pk_bf16(w[0], w[1]); p.y = cvt_pk_bf16(w[2], w[3]); o8b[64 * j] = p;
        if (o8) { int q = __builtin_amdgcn_cvt_pk_fp8_f32(w[0], w[1], 0, false); q = __builtin_amdgcn_cvt_pk_fp8_f32(w[2], w[3], q, true); o8[64 * j + lane] = (unsigned)q; } }
    return rs;
}
__device__ __forceinline__ f32x2 cossin(float xf) {
    const double x = (double)xf;
    const double k = __builtin_rint(x * 0.63661977236758134308);
    double r = __builtin_fma(-k, 1.57079632679489655800e+00, x); r = __builtin_fma(-k, 6.12323399573676603587e-17, r);
    const double r2 = r * r;
    double s = -2.5052108385441718775e-08; s = s * r2 + 2.7557319223985890653e-06; s = s * r2 - 1.9841269841269841253e-04; s = s * r2 + 8.3333333333333332177e-03; s = s * r2 - 1.6666666666666665741e-01; s = r + r * r2 * s;
    double c = -2.7557319223985888e-07; c = c * r2 + 2.4801587301587302e-05; c = c * r2 - 1.3888888888888889e-03; c = c * r2 + 4.1666666666666664e-02; c = c * r2 - 0.5; c = 1.0 + r2 * c;
    const int q = ((int)k) & 3;
    const double cc = (q == 0) ? c : (q == 1) ? -s : (q == 2) ? -c : s;
    const double ss = (q == 0) ? s : (q == 1) ? c : (q == 2) ? -s : -c;
    return (f32x2){(float)cc, (float)ss};
}

struct AttnArgs { const bf16_t* q; const bf16_t* k; const bf16_t* v; unsigned char* y; float ysc; };
template <int MODE>
__device__ __forceinline__ void attn_phase(LAS unsigned char* lds, const AttnArgs& A, int G, int c) {
    constexpr int DQK = MODE == 0 ? 192 : 128, NKS = DQK / 16, KP = DQK * 2 + 16, VP = 320, QP = MODE == 0 ? 3072 : 2048;
    constexpr int KCH = DQK / 8;
    constexpr int KB0 = 0, KBS = 64 * KP, VB0 = 2 * KBS, VBS = 64 * VP, FLAG0 = VB0 + 2 * VBS;
    const int tid = threadIdx.x, wid = __builtin_amdgcn_readfirstlane(tid >> 6), lane = tid & 63, hi = lane >> 5, li = lane & 15;
    LAS unsigned* flags = (LAS unsigned*)(lds + FLAG0);
    const int xk = c & 7, xa = c >> 3;
    for (int it = 0; it < 2 * ((512 + G - 1) / G); ++it) {
        const int round = it >> 1, half = it & 1;
        int bh, qb;
        if (G == 256) { bh = 2 * xk + (xa >> 4) + 16 * round; qb = xa & 15; if (round >= 2) break; }
        else { const int p = c + round * G; if (p >= 512) break; bh = p >> 4; qb = p & 15; }
        if (half) qb = 31 - qb;
        const int b = bh >> 4, h = bh & 15, t0 = qb * 256, jmax = 4 * qb + 3, ntile = jmax + 1;
        const size_t rowbase = (size_t)b * SEQ;
        const int wrow0 = t0 + 32 * wid;
        const int tq = wrow0 + (lane & 31);
        bf16x8 qf[NKS];
        { const bf16_t* qp = A.q + (rowbase + tq) * QP + h * DQK + 8 * hi;
#pragma unroll
          for (int ks = 0; ks < NKS; ++ks) qf[ks] = *(const bf16x8*)(qp + 16 * ks); }
        f32x16 o[4];
#pragma unroll
        for (int d = 0; d < 4; ++d)
#pragma unroll
            for (int r = 0; r < 16; ++r) o[d][r] = 0.f;
        float m_run = -1e30f, l_run = 0.f, r_run = 0.f;
        auto issue_dma = [&](int j, int buf) {
            constexpr int KCPR = KCH + 1, KLOADS = KCPR, VLOADS = 20, KPB = MODE == 0 ? 6144 : 4096;
            const char* kbase = (const char*)A.k + ((rowbase + (size_t)64 * j) * KPB + (size_t)h * (DQK * 2));
            const char* vbase = (const char*)A.v + ((rowbase + (size_t)64 * j) * 4096 + (size_t)h * 256);
#pragma unroll
            for (int i = 0; i < (KLOADS + 7) / 8; ++i) { const int wl = wid + 8 * i;
                if (wl < KLOADS) { const int gch = wl * 64 + lane, row = gch / KCPR; int cc = gch % KCPR; if (cc == KCH) cc = 0;
                    __builtin_amdgcn_global_load_lds((const unsigned*)(kbase + (unsigned)(row * KPB + cc * 16)), (LAS unsigned*)(lds + KB0 + buf * KBS + wl * 1024), 16, 0, 0); } }
#pragma unroll
            for (int i = 0; i < (VLOADS + 7) / 8; ++i) { const int wl = wid + 8 * i;
                if (wl < VLOADS) { const int gch = wl * 64 + lane, row = gch / 20, cc = (gch % 20) & 15;
                    __builtin_amdgcn_global_load_lds((const unsigned*)(vbase + (unsigned)(row * 4096 + cc * 16)), (LAS unsigned*)(lds + VB0 + buf * VBS + wl * 1024), 16, 0, 0); } }
        };
        __syncthreads();
        issue_dma(MODE == 0 ? 0 : jmax, 0);
        VM_WAIT();
        __syncthreads();
        bool wdone = false;
        for (int i = 0; i < ntile; ++i) {
            const int j = MODE == 0 ? i : jmax - i, buf = i & 1;
            const bool more = i + 1 < ntile;
            if (more) issue_dma(MODE == 0 ? j + 1 : j - 1, buf ^ 1);
            const int k0 = 64 * j;
            bool active;
            if (MODE == 0) active = k0 <= wrow0 + 31; else active = (k0 < wrow0 + 31) && !wdone;
            if (active) {
                const LAS unsigned char* kb = lds + KB0 + buf * KBS + (lane & 31) * KP + hi * 16;
                const LAS unsigned char* vb = lds + VB0 + buf * VBS + (4 * hi + (li >> 2)) * VP + (16 * ((lane >> 4) & 1) + 4 * (li & 3)) * 2;
                const int dq0 = tq - k0 - 4 * hi;
#pragma unroll
                for (int kk = 0; kk < 2; ++kk) {
                    const int kt = MODE == 0 ? kk : 1 - kk;
                    const int dq = dq0 - 32 * kt;
                    if (MODE == 0 ? (k0 + 32 * kt > wrow0 + 31) : (k0 + 32 * kt >= wrow0 + 31)) continue;
                    f32x16 p;
#pragma unroll
                    for (int r = 0; r < 16; ++r) p[r] = 0.f;
#pragma unroll
                    for (int ks = 0; ks < NKS; ++ks) {
                        const bf16x8 a0 = *(const LAS bf16x8*)(kb + kt * 32 * KP + ks * 32);
                        p = __builtin_amdgcn_mfma_f32_32x32x16_bf16(a0, qf[ks], p, 0, 0, 0);
                    }
                    if (MODE == 0) {
                        if (k0 + 32 * kt + 31 > wrow0) {
#pragma unroll
                            for (int r = 0; r < 16; ++r) { const int cr = (r & 3) + 8 * (r >> 2); if (cr > dq) p[r] = -__builtin_inff(); }
                        }
                        float pmax = p[0];
#pragma unroll
                        for (int r = 1; r < 16; ++r) pmax = fmaxf(pmax, p[r]);
                        pmax = xor32_max(pmax);
                        const float mn = pmax > m_run + 8.f ? pmax : m_run, alpha = fexp2(m_run - mn); m_run = mn;
                        float ps = 0.f;
#pragma unroll
                        for (int r = 0; r < 16; ++r) { p[r] = fexp2(p[r] - mn); ps += p[r]; }
                        ps = xor32_sum(ps);
                        l_run = l_run * alpha + ps;
                        if (!__all(alpha == 1.f)) {
#pragma unroll
                            for (int d = 0; d < 4; ++d)
#pragma unroll
                                for (int r = 0; r < 16; ++r) o[d][r] *= alpha;
                        }
                    } else {
                        float lk[16];
#pragma unroll
                        for (int r = 0; r < 16; ++r) { const int cr = (r & 3) + 8 * (r >> 2); const float z = p[r];
                            const float sp = fmaxf(z, 0.f) + flog2(1.f + fexp2(-fabsf(z)));
                            lk[r] = (cr < dq) ? -sp : 0.f; }
                        float sg[4], pg[4];
#pragma unroll
                        for (int g = 0; g < 4; ++g) { sg[g] = (lk[4 * g] + lk[4 * g + 1]) + (lk[4 * g + 2] + lk[4 * g + 3]); pg[g] = xor32_partner(sg[g], hi); }
                        const float t3 = sg[3] + pg[3], t2 = sg[2] + pg[2], t1 = sg[1] + pg[1], t0s = sg[0] + pg[0];
                        float ub[4]; ub[3] = 0.f; ub[2] = t3; ub[1] = t3 + t2; ub[0] = t3 + t2 + t1;
#pragma unroll
                        for (int g = 0; g < 4; ++g) {
                            float aft = r_run + ub[g] + (hi ? 0.f : pg[g]);
#pragma unroll
                            for (int e = 3; e >= 0; --e) { const int r = 4 * g + e; const int cr = (r & 3) + 8 * (r >> 2);
                                const float w = (cr < dq) ? fexp2(p[r] + lk[r] + aft) : 0.f; aft += lk[r]; p[r] = w; }
                        }
                        r_run += (t3 + t2) + (t1 + t0s);
                    }
#pragma unroll
                    for (int s = 0; s < 2; ++s) {
                        u32x4 w0;
                        w0.x = cvt_pk_bf16(p[8 * s + 0], p[8 * s + 1]); w0.y = cvt_pk_bf16(p[8 * s + 2], p[8 * s + 3]); w0.z = cvt_pk_bf16(p[8 * s + 4], p[8 * s + 5]); w0.w = cvt_pk_bf16(p[8 * s + 6], p[8 * s + 7]);
                        const bf16x8 pf = __builtin_bit_cast(bf16x8, w0);
#pragma unroll
                        for (int d = 0; d < 4; ++d) {
                            const s16x4 lo = __builtin_amdgcn_ds_read_tr16_b64_v4i16((LAS s16x4*)(vb + (32 * kt + 16 * s) * VP + d * 64));
                            const s16x4 hh = __builtin_amdgcn_ds_read_tr16_b64_v4i16((LAS s16x4*)(vb + (32 * kt + 16 * s + 8) * VP + d * 64));
                            const bf16x8 af = {lo[0], lo[1], lo[2], lo[3], hh[0], hh[1], hh[2], hh[3]};
                            o[d] = __builtin_amdgcn_mfma_f32_32x32x16_bf16(af, pf, o[d], 0, 0, 0);
                        }
                    }
                }
            }
            if (MODE == 1) {
                wdone = wdone || (bool)__all(r_run < SB_DONE);
                if (lane == 0) flags[(i & 1) * 8 + wid] = wdone ? 1u : 0u;
            }
            VM_WAIT();
            __syncthreads();
            if (MODE == 1) {
                unsigned alld = 1u;
#pragma unroll
                for (int w = 0; w < 8; ++w) alld &= flags[(i & 1) * 8 + w];
                if (alld) break;
            }
        }
        const float inv = (MODE == 0 ? frcp(l_run) : 1.f) * A.ysc;
        unsigned char* yp = A.y + (rowbase + tq) * 2048 + h * 128 + 4 * hi;
#pragma unroll
        for (int d = 0; d < 4; ++d)
#pragma unroll
            for (int g = 0; g < 4; ++g) { int w = __builtin_amdgcn_cvt_pk_fp8_f32(o[d][4 * g] * inv, o[d][4 * g + 1] * inv, 0, false); w = __builtin_amdgcn_cvt_pk_fp8_f32(o[d][4 * g + 2] * inv, o[d][4 * g + 3] * inv, w, true);
                *(unsigned*)(yp + 32 * d + 8 * g) = (unsigned)w; }
    }
}

__device__ __forceinline__ const float* karg_in(int i) { const char* ka = (const char*)__builtin_amdgcn_kernarg_segment_ptr(); asm volatile("" : "+s"(ka)); return *(const float* const*)(ka + 8 * i); }
struct Args { const float* in[19]; const int* pos; float* out; unsigned char* ws; int ph_lo, ph_hi, li, bar_on; };

__global__ void __launch_bounds__(NTHREADS, 2) hybrid_fwd(Args args) {
    extern __shared__ __attribute__((aligned(16))) unsigned char lds_raw[];
    LAS unsigned char* lds = (LAS unsigned char*)lds_raw;
    volatile LAS unsigned* MISC = (volatile LAS unsigned*)(lds + MISC_OFF);
    const int tid = threadIdx.x, lane = tid & 63, wave = __builtin_amdgcn_readfirstlane(tid >> 6);
    const int G = gridDim.x, c = blockIdx.x;
    unsigned char* ws = args.ws;
    if (tid < 16) MISC[tid] = 0u;
    __syncthreads();
    XcdBarrier bar; bar.bar = (unsigned*)(ws + WS_CTL) + args.li * XCD_BAR_WORDS; bar.x = 0; bar.st = nullptr;
    const bool bar_on = args.bar_on != 0;
    if (bar_on) bar = xcd_barrier_post((unsigned*)(ws + WS_CTL) + args.li * XCD_BAR_WORDS, MISC + 8);
#define GRID_BAR() do { if (bar_on) xcd_barrier(bar); } while (0)
    const int lo = args.ph_lo, hi_ph = args.ph_hi;
#ifndef ONLY_PHASE
#define ONLY_PHASE -1
#endif
#define IN(k) ((ONLY_PHASE < 0 || ONLY_PHASE == (k)) && lo <= (k) && (k) < hi_ph)

#define I_x (karg_in(0))
#define I_mem (karg_in(1))
#define I_g_mix (karg_in(3))
#define I_w_in (karg_in(4))
#define I_g_q (karg_in(5))
#define I_w_uq (karg_in(6))
#define I_g_kv (karg_in(7))
#define I_w_ukv (karg_in(8))
#define I_g_mem (karg_in(9))
#define I_w_mkv (karg_in(10))
#define I_w_br (karg_in(11))
#define I_w_out (karg_in(12))
#define I_g_ffn (karg_in(13))
#define I_w_pq (karg_in(14))
#define I_subk (karg_in(15))
#define I_u_tab (karg_in(16))
#define I_v_tab (karg_in(17))
#define I_g_fin (karg_in(18))
#define RS ((float*)(ws + WS_RS))
#define SSQ_DQ ((float*)(ws + WS_SSQ_DQ))
#define SSQ_DKV ((float*)(ws + WS_SSQ_DKV))
#define SSQ_H ((float*)(ws + WS_SSQ_H))
#define CS ((f32x2*)(ws + WS_CS))
#define MEMN ((bf16_t*)(ws + WS_MEMN))
#define MK ((bf16_t*)(ws + WS_MK))
#define MVT ((bf16_t*)(ws + WS_MVT))
#define SKB ((bf16_t*)(ws + WS_SKB))
#define WUQ ((bf16_t*)(ws + WS_WUQ))
#define WUKV ((bf16_t*)(ws + WS_WUKV))
#define WMKV ((bf16_t*)(ws + WS_WMKV))
#define WBR ((bf16_t*)(ws + WS_WBR))
#define WOUT ((bf16_t*)(ws + WS_WOUT))
#define WPQ ((bf16_t*)(ws + WS_WPQ))
#define YMLA ((bf16_t*)(ws + WS_YMLA))
#define XB ((bf16_t*)(ws + WS_XB))
#define WIN ((bf16_t*)(ws + WS_WIN))
#define QMLA ((bf16_t*)(ws + WS_QMLA))
#define KF ((bf16_t*)(ws + WS_KF))
#define VV ((bf16_t*)(ws + WS_VV))
#define SMEM ((float*)(ws + WS_SMEM))
#define H1B ((bf16_t*)(ws + WS_H1B))
#define ROUTE ((u32x2*)(ws + WS_ROUTE))
#define SBQ ((bf16_t*)(ws + WS_SBQ))
#define SBK ((bf16_t*)(ws + WS_SBK))
#define SBV ((bf16_t*)(ws + WS_SBV))
#define DQ ((bf16_t*)(ws + WS_DQ))
#define DKV ((bf16_t*)(ws + WS_DKV))
#define MEMQ ((bf16_t*)(ws + WS_MEMQ))
#define GATES ((bf16_t*)(ws + WS_GATES))
#define MERGED ((bf16_t*)(ws + WS_MERGED))
#define PQ ((bf16_t*)(ws + WS_PQ))
#define UTAB ((bf16_t*)(ws + WS_UTAB))
#define VTAB ((bf16_t*)(ws + WS_VTAB))
#define DEF_GIDX() int c_op = c; asm volatile("" : "+s"(c_op)); const int gw = c_op * NWAVES + wave, NGW = G * NWAVES, gt = c_op * NTHREADS + tid, NGT = G * NTHREADS; (void)gw; (void)NGW; (void)gt; (void)NGT

    if (IN(0)) {
        DEF_GIDX();
        LAS float* scr = (LAS float*)(lds + wave * 16384);
        constexpr int I_WIN = 64 * (NPROJ_BF / 32), I_WG8 = 64 * (NPROJ_F8 / 32), I_UQ = 16 * 96, I_UKV = 8 * 128, I_MKV = 64 * 128, I_BR = 32 * 128, I_OUT = 64 * 128, I_PQ = 64 * 64;
        constexpr int NITEMS = I_WIN + I_WG8 + I_UQ + I_UKV + I_MKV + 3 * I_BR + I_OUT + I_PQ;
        for (int it = gw; it < NITEMS; it += NGW) {
            int r = it;
            if (r < I_WIN) { tr_item(I_w_in, 4096, IN_COLS, WIN, I_g_mix, scr, r, NPROJ_BF / 32, lane, MapWin()); continue; } r -= I_WIN;
            if (r < I_WG8) { tr_item<MapGate, true>(I_w_in, 4096, IN_COLS, (bf16_t*)(ws + WS_WIN8), I_g_mix, scr, r, NPROJ_F8 / 32, lane, MapGate(), WG8_SC); continue; } r -= I_WG8;
            if (r < I_UQ) { tr_item(I_w_uq, 1024, 3072, WUQ, I_g_q, scr, r, 96, lane, MapUq()); continue; } r -= I_UQ;
            if (r < I_UKV) { tr_item(I_w_ukv, 512, 4096, WUKV, I_g_kv, scr, r, 128, lane, MapId()); continue; } r -= I_UKV;
            if (r < I_MKV) { tr_item(I_w_mkv, 4096, 4096, WMKV, nullptr, scr, r, 128, lane, MapId()); continue; } r -= I_MKV;
            if (r < 3 * I_BR) { const int z = r / I_BR; tr_item<MapId, true>(I_w_br + (size_t)z * 2048 * 4096, 2048, 4096, (bf16_t*)((unsigned char*)WBR + (size_t)z * 4096 * 2048), nullptr, scr, r % I_BR, 128, lane, MapId(), WBR_SC); continue; } r -= 3 * I_BR;
            if (r < I_OUT) { tr_item<MapId, true>(I_w_out, 4096, 4096, WOUT, nullptr, scr, r, 128, lane, MapId(), WOUT_SC); continue; } r -= I_OUT;
            tr_item(I_w_pq, 4096, 2048, WPQ, I_g_ffn, scr, r, 64, lane, MapId());
        }
        for (int m = gw; m < T; m += NGW) { const float rs = row_to_bf16(I_x + (size_t)m * D, XB + (size_t)m * D, nullptr, lane, (unsigned*)(ws + WS_XB8) + (size_t)m * (D / 4)); if (lane == 0) RS[m] = rs; }
        for (int m = gw; m < 512; m += NGW) (void)row_to_bf16(I_mem + (size_t)m * D, MEMN + (size_t)m * D, I_g_mem, lane);
        for (int i = gt; i < T * 32; i += NGT) { const int t = i >> 5, f = i & 31;
            const float freq = exp2f(-(float)f * (13.287712379549449f / 32.f));
            const float ang = (float)((const int*)karg_in(19))[t] * freq; CS[i] = cossin(ang); }
        for (int i = gt; i < 8 * 2 * 128 * 128 / 4; i += NGT) { const f32x4 v = ((const f32x4*)I_subk)[i]; u32x2 w; w.x = cvt_pk_bf16(v[0], v[1]); w.y = cvt_pk_bf16(v[2], v[3]); ((u32x2*)SKB)[i] = w; }
        GRID_BAR();
    }
    if (IN(1)) {
        { pg8::SchedB S; S.init(T, NPROJ_BF, 1, G, c, XB, WIN, D, D, 0, 0);
          EpiProj E{RS, SBQ, DQ, DKV, MEMQ, GATES, SSQ_DQ, SSQ_DKV, 0, 1.f};
          pg8::gemm_phase<EpiProj, pg8::SchedB>(lds, pg8::Gemm{D, D, D}, S, E); }
        { pg8::SchedB S; S.init(T, NPROJ_F8, 1, G, c, ws + WS_XB8, ws + WS_WIN8, D / 2, D / 2, 0, 0);
          EpiProj E{RS, SBQ, DQ, DKV, MEMQ, GATES, SSQ_DQ, SSQ_DKV, 31, 1.f / WG8_SC};
          pg8::gemm_phase_f8<EpiProj, pg8::SchedB>(lds, pg8::Gemm{D, D, D}, S, E); }
        { const int cm = G >= 64 ? (c >= G - 32 ? c - (G - 32) : c + 32) : c;
          pg8::SchedB S; S.init(512, 4096, 1, G, cm, MEMN, WMKV, D, D, 0, 0);
          EpiMemKV E{MK, MVT};
          pg8::gemm_phase<EpiMemKV, pg8::SchedB>(lds, pg8::Gemm{D, D, D}, S, E); }
        GRID_BAR();
    }
    if (IN(2)) {
        { pg8::SchedB S; S.init(T, 3072, 1, G, c, DQ, WUQ, 1024, 1024, 0, 0);
          EpiUQ E{SSQ_DQ, CS, QMLA};
          pg8::gemm_phase<EpiUQ, pg8::SchedB>(lds, pg8::Gemm{1024, 1024, 1024}, S, E); }
        { pg8::SchedB S; S.init(T, 4096, 1, G, c, DKV, WUKV, 768, 512, 0, 0);
          EpiUKV E{SSQ_DKV, KF, VV};
          pg8::gemm_phase<EpiUKV, pg8::SchedB>(lds, pg8::Gemm{512, 768, 512}, S, E); }
        { pg8::SchedB S; S.init(SEQ, 256, 8, G, c, MEMQ, MK, 2048, 2048, 0, 0);
          S.zA = 0; S.zB = 0;
          struct SchedMS : pg8::SchedB {
              __device__ __forceinline__ const char* pa(const Unit& u) const { return A + ((size_t)(u.z >> 2) * SEQ * 2048 + (size_t)(u.z & 3) * 512) * 2 + (size_t)u.pm * tA; }
              __device__ __forceinline__ const char* pb(const Unit& u) const { return B + ((size_t)(u.z >> 2) * 256 * 2048 + (size_t)(u.z & 3) * 512) * 2 + (size_t)u.pn * tB; }
          } S2; (pg8::SchedB&)S2 = S;
          EpiMemS E{SMEM};
          pg8::gemm_phase<EpiMemS, SchedMS>(lds, pg8::Gemm{512, 2048, 2048}, S2, E); }
        {
          struct SchedVW : pg8::SchedB {
              __device__ __forceinline__ const char* pa(const Unit& u) const { return A + (size_t)(u.z & 3) * 512 + (size_t)u.pm * tA; }
              __device__ __forceinline__ const char* pb(const Unit& u) const { return B + (size_t)(u.z >> 2) * 256 * 2048 + (size_t)(u.z & 3) * 512 + (size_t)u.pn * tB; }
          } SV; SV.init(4096, 256, 8, G, c, (const unsigned char*)WBR + (size_t)2 * 4096 * 2048, (const unsigned char*)MVT, 1024, 1024, 0, 0);
          EpiVW EV{ws + WS_BT};
          pg8::gemm_phase_f8<EpiVW, SchedVW>(lds, pg8::Gemm{512, 2048, 2048}, SV, EV); }
        DEF_GIDX();
        for (int i = gt; i < T * 32; i += NGT) { const int t = i >> 5, f = i & 31;
            const float t1 = bf_lo((unsigned)DKV[(size_t)t * 768 + 512 + f]), t2 = bf_lo((unsigned)DKV[(size_t)t * 768 + 544 + f]); const f32x2 cs = CS[i];
            const unsigned w = cvt_pk_bf16(t1 * cs.x - t2 * cs.y, t1 * cs.y + t2 * cs.x);
#pragma unroll
            for (int hh = 0; hh < 16; ++hh) ((unsigned*)(KF + (size_t)t * 3072 + hh * 192 + 128))[f] = w; }
        GRID_BAR();
    }
    if (IN(3)) {
        DEF_GIDX();
        for (int r = gw; r < T * 4; r += NGW) { float* sp = SMEM + (size_t)r * 256; const f32x4 v = ((const f32x4*)sp)[lane];
            float mx = fmaxf(fmaxf(v[0], v[1]), fmaxf(v[2], v[3]));
#pragma unroll
            for (int o = 1; o < 64; o <<= 1) mx = fmaxf(mx, __shfl_xor(mx, o));
            const float e0 = fexp2(v[0] - mx), e1 = fexp2(v[1] - mx), e2 = fexp2(v[2] - mx), e3 = fexp2(v[3] - mx);
            const float inv = frcp(wave_sum((e0 + e1) + (e2 + e3)));
            const float ps = inv * P8_SC;
            int q8 = __builtin_amdgcn_cvt_pk_fp8_f32(e0 * ps, e1 * ps, 0, false); q8 = __builtin_amdgcn_cvt_pk_fp8_f32(e2 * ps, e3 * ps, q8, true);
            ((unsigned*)(ws + WS_Y8C + (size_t)(r >> 2) * 2048 + (r & 3) * 256))[lane] = (unsigned)q8; }
        __syncthreads();
        { const AttnArgs A{SBQ, SBK, SBV, ws + WS_Y8A, 1.f}; attn_phase<1>(lds, A, G, c); }
        __syncthreads();
        { const AttnArgs A{QMLA, KF, VV, ws + WS_Y8B, YB_SC}; attn_phase<0>(lds, A, G, c); }
        GRID_BAR();
    }
    if (IN(5)) {
        pg8::SchedM S; S.nM = T / 256; S.nN = D / 256; S.G = G; S.c = c;
        S.ws = (const char*)ws; S.B = (const char*)WBR; S.BT = (const char*)(ws + WS_BT); S.o0 = 0; S.o1 = 0; S.o2 = 0;
        S.tA = (size_t)256 * 2048; S.tB = (size_t)256 * 2048; S.zB = (size_t)4096 * 2048;
        EpiMerge E{GATES, MERGED, ws + WS_MG8};
        pg8::gemm_phase_f8<EpiMerge, pg8::SchedM>(lds, pg8::Gemm{2048, 2048, 2048}, S, E);
        GRID_BAR();
    }
    if (IN(6)) {
        { pg8::SchedB S; S.init(T, D, 1, G, c, ws + WS_MG8, WOUT, D / 2, D / 2, 0, 0);
          EpiOut E{I_x, (float*)karg_in(20), H1B, SSQ_H, 1.f / (MG_SC * WOUT_SC)};
          pg8::gemm_phase_f8<EpiOut, pg8::SchedB>(lds, pg8::Gemm{D, D, D}, S, E); }
        DEF_GIDX();
        for (size_t w = gw; w < (size_t)NEXP * 4; w += NGW) {
            const size_t e = w >> 2; const int seg = (int)(w & 3);
            const f32x4* up = (const f32x4*)I_u_tab + e * (D / 4) + seg * 256 + lane; const f32x4* vp = (const f32x4*)I_v_tab + e * (D / 4) + seg * 256 + lane;
            f32x4 ua[4], va[4];
#pragma unroll
            for (int q = 0; q < 4; ++q) { ua[q] = up[64 * q]; va[q] = vp[64 * q]; }
#pragma unroll
            for (int q = 0; q < 4; ++q) {
                const f32x4 a = ua[q] * *(const f32x4*)(I_g_ffn + seg * 1024 + q * 256 + lane * 4) * PEER_SCU, p = va[q] * PEER_SCV;
                int du = __builtin_amdgcn_cvt_pk_fp8_f32(a[0], a[1], 0, false); du = __builtin_amdgcn_cvt_pk_fp8_f32(a[2], a[3], du, true);
                int dv = __builtin_amdgcn_cvt_pk_fp8_f32(p[0], p[1], 0, false); dv = __builtin_amdgcn_cvt_pk_fp8_f32(p[2], p[3], dv, true);
                const size_t dst = ((size_t)(seg * 4 + q) * NEXP + e) * 64 + lane;
                ((unsigned*)UTAB)[dst] = (unsigned)du; ((unsigned*)VTAB)[dst] = (unsigned)dv;
            }
        }
        GRID_BAR();
    }
    if (IN(7)) {
        pg8::SchedB S; S.init(T, 2048, 1, G, c, H1B, WPQ, D, D, 0, 0);
        EpiPQ E{SSQ_H, PQ};
        pg8::gemm_phase<EpiPQ, pg8::SchedB>(lds, pg8::Gemm{D, D, D}, S, E);
        GRID_BAR();
    }
    if (IN(8)) {
        constexpr int SCP = 129;
        LAS float* SC = (LAS float*)lds;
        LAS unsigned* LST = (LAS unsigned*)(lds + 2 * 128 * SCP * 4);
        LAS unsigned char* CT = lds + 2 * 128 * SCP * 4 + 128 * 33 * 4;
        if (tid < 50) { int id = 0, fi = 0, fj = 0; for (int i = 0; i < 16; ++i) for (int j = 0; j < 16 / (i + 1); ++j) { if (id == tid) { fi = i; fj = j; } ++id; } CT[2 * tid] = (unsigned char)fi; CT[2 * tid + 1] = (unsigned char)fj; }
        for (int un = c; un < 128 * 8; un += G) {
            const int tile = un >> 3, h = un & 7, tok0 = tile * 128;
            __syncthreads();
            {
                const int p = wave >> 2, tt = wave & 3, hi = lane >> 5;
                const bf16_t* qp = PQ + (size_t)(tok0 + 32 * tt + (lane & 31)) * 2048 + h * 256 + p * 128 + 8 * hi;
                bf16x8 af[8];
#pragma unroll
                for (int ks = 0; ks < 8; ++ks) af[ks] = *(const bf16x8*)(qp + 16 * ks);
#pragma unroll
                for (int nt = 0; nt < 4; ++nt) {
                    const bf16_t* kp = SKB + ((size_t)(h * 2 + p) * 128 + 32 * nt + (lane & 31)) * 128 + 8 * hi;
                    f32x16 acc;
#pragma unroll
                    for (int r = 0; r < 16; ++r) acc[r] = 0.f;
#pragma unroll
                    for (int ks = 0; ks < 8; ++ks) acc = __builtin_amdgcn_mfma_f32_32x32x16_bf16(af[ks], *(const bf16x8*)(kp + 16 * ks), acc, 0, 0, 0);
#pragma unroll
                    for (int r = 0; r < 16; ++r) SC[(p * 128 + 32 * tt + (r & 3) + 8 * (r >> 2) + 4 * hi) * SCP + 32 * nt + (lane & 31)] = acc[r];
                }
            }
            __syncthreads();
            if (tid < 256) {
                const int p = tid >> 7, tk = tid & 127;
                const LAS float* row = SC + (p * 128 + tk) * SCP;
                unsigned L[16];
#pragma unroll
                for (int s = 0; s < 16; ++s) L[s] = 0u;
#pragma unroll 4
                for (int n = 0; n < 128; ++n) {
                    unsigned u = __float_as_uint(row[n]); u = (u & 0x80000000u) ? ~u : (u | 0x80000000u);
                    unsigned xk = (u & ~127u) | (unsigned)(127 - n);
#pragma unroll
                    for (int s = 0; s < 16; ++s) { const unsigned hi2 = L[s] > xk ? L[s] : xk, lo2 = L[s] > xk ? xk : L[s]; L[s] = hi2; xk = lo2; }
                }
#pragma unroll
                for (int s = 0; s < 16; ++s) LST[tk * 33 + p * 16 + s] = L[s];
            } else {
                const u32x4* tu = (const u32x4*)UTAB + (size_t)un * 4096 + (tid - 256); const u32x4* tv = (const u32x4*)VTAB + (size_t)un * 4096 + (tid - 256);
                u32x4 ax = {0u, 0u, 0u, 0u};
#pragma unroll 8
                for (int q = 0; q < 16; ++q) { ax ^= tu[256 * q]; ax ^= tv[256 * q]; }
                if ((ax[0] ^ ax[1] ^ ax[2] ^ ax[3]) == 0x12345678u && ax[1] == 0x9abcdef0u) ((unsigned*)(ws + WS_CTL))[4096 + (tid & 255)] = ax[2];
            }
            __syncthreads();
            if (tid < 128) {
                const LAS unsigned* L = LST + tid * 33;
                unsigned Kk[16];
#pragma unroll
                for (int s = 0; s < 16; ++s) Kk[s] = 0u;
                float v0[16], v1[16];
#pragma unroll
                for (int s = 0; s < 16; ++s) { unsigned a = L[s] & ~127u, b = L[16 + s] & ~127u; a = (a & 0x80000000u) ? (a & 0x7fffffffu) : ~a; b = (b & 0x80000000u) ? (b & 0x7fffffffu) : ~b; v0[s] = __uint_as_float(a); v1[s] = __uint_as_float(b); }
                int id = 0;
#pragma unroll
                for (int i = 0; i < 16; ++i)
#pragma unroll
                    for (int j = 0; j < 16 / (i + 1); ++j) {
                        unsigned u = __float_as_uint(v0[i] + v1[j]); u = (u & 0x80000000u) ? ~u : (u | 0x80000000u);
                        unsigned xk = (u & ~63u) | (unsigned)(63 - id); ++id;
#pragma unroll
                        for (int s = 0; s < 16; ++s) { const unsigned hi2 = Kk[s] > xk ? Kk[s] : xk, lo2 = Kk[s] > xk ? xk : Kk[s]; Kk[s] = hi2; xk = lo2; }
                    }
                float val[16]; float sum = 0.f;
#pragma unroll
                for (int s = 0; s < 16; ++s) { unsigned a = Kk[s] & ~63u; a = (a & 0x80000000u) ? (a & 0x7fffffffu) : ~a; val[s] = __uint_as_float(a); }
#pragma unroll
                for (int s = 15; s >= 0; --s) { val[s] = fexp2((val[s] - val[0]) * LOG2E); sum += val[s]; }
                const float inv = 1.f / sum;
                u32x2* rp = ROUTE + (size_t)(tok0 + tid) * 128 + h * 16;
#pragma unroll
                for (int s = 0; s < 16; ++s) { const int cid = 63 - (int)(Kk[s] & 63u); const int ci = CT[2 * cid], cj = CT[2 * cid + 1];
                    const unsigned e = (127u - (L[ci] & 127u)) * 128u + (127u - (L[16 + cj] & 127u));
                    rp[s] = (u32x2){e, __float_as_uint(val[s] * inv)}; }
            }
        }
        GRID_BAR();
    }
    if (IN(9)) {
        LAS unsigned char* wl = lds + wave * 20480;
        LAS unsigned short* SE = (LAS unsigned short*)wl;
        LAS float* HA = (LAS float*)(wl + 1024);
        LAS unsigned char* HBp = wl + 3072;
        LAS unsigned char* RB = wl + 4096;
        LAS unsigned* TMP = (LAS unsigned*)RB;
        unsigned short* GS = (unsigned short*)(ws + WS_PQ);
        const unsigned sv_nloc = MISC[8], sv_nx = MISC[9];
        __syncthreads();
        const int l16 = lane & 15, lg = lane >> 4;
        const int rot = 2 * (c & 7);
#define WFENCE() asm volatile("s_waitcnt lgkmcnt(0)" ::: "memory")
#define H8C(x) __builtin_amdgcn_fmed3f((x) * H8_SC, -448.f, 448.f)
        for (int tg = c * NWAVES + wave; tg < T / 8; tg += G * NWAVES) {
            const int tb = tg * 8;
            WFENCE();
            GAS float* outp = (GAS float*)karg_in(20); const GAS float* gfin = (const GAS float*)I_g_fin;
#pragma unroll 1
            for (int pass = 0; pass < 2; ++pass) {
                const int ip0 = 0, tp = tb + 4 * pass;
                WFENCE();
#pragma unroll 1
                for (int i = 0; i < 4; ++i) {
                    const u32x2 r0 = ROUTE[(size_t)(tp + i) * 128 + lane], r1 = ROUTE[(size_t)(tp + i) * 128 + lane + 64];
                    const unsigned k0 = (r0.x << 7) | (unsigned)lane, k1 = (r1.x << 7) | (unsigned)(lane + 64);
                    TMP[lane] = k0; TMP[lane + 64] = k1;
                    WFENCE();
                    int ra = 0, rb = 0;
#pragma unroll 8
                    for (int m = 0; m < 128; ++m) { const unsigned km = TMP[m]; ra += km < k0 ? 1 : 0; rb += km < k1 ? 1 : 0; }
                    SE[i * 128 + ra] = (unsigned short)r0.x; SE[i * 128 + rb] = (unsigned short)r1.x;
                    GS[(size_t)(tp + i) * 128 + ra] = (unsigned short)cvt_pk_bf16(__uint_as_float(r0.y), 0.f); GS[(size_t)(tp + i) * 128 + rb] = (unsigned short)cvt_pk_bf16(__uint_as_float(r1.y), 0.f);
                    HA[i * 128 + lane] = 0.f; HA[i * 128 + lane + 64] = 0.f;
                    WFENCE();
                }
                {
                    const unsigned scl1 = 0x7f7f7f7fu;
                    const int nrow = l16;
                    const int fo0 = nrow * 256 + (((2 * lg) ^ nrow) * 16), fo1 = nrow * 256 + (((2 * lg + 1) ^ nrow) * 16);
                    const int hae = 4 * (l16 & 3) + (l16 >> 2);
                    int wb = 0, rb = 0;
#define CAT8(x, y) __builtin_shufflevector(__builtin_bit_cast(i32x4, x), __builtin_bit_cast(i32x4, y), 0, 1, 2, 3, 4, 5, 6, 7)
#define ISSUE_STEP(bq, rq, iq) do { const u32x2 ew2_ = *(const LAS u32x2*)(SE + (iq) * 128 + 16 * (rq) + 4 * lg); const unsigned ew_[4] = {ew2_.x & 0xffffu, ew2_.x >> 16, ew2_.y & 0xffffu, ew2_.y >> 16}; LAS unsigned char* dst_ = RB + wb * 4096; \
                        _Pragma("unroll") for (int q_ = 0; q_ < 4; ++q_) { const int n_ = 4 * q_ + lg; \
                            __builtin_amdgcn_global_load_lds((const unsigned*)((bq) + (size_t)ew_[q_] * 256 + ((l16 ^ n_) * 16)), (LAS unsigned*)(dst_ + q_ * 1024), 16, 0, 0); } \
                        wb = (wb + 1) & 3; } while (0)
                    const unsigned char* ub = (const unsigned char*)UTAB + (size_t)rot * NEXP * 256;
                    ISSUE_STEP(ub, 0, 0); ISSUE_STEP(ub, 0, 1); ISSUE_STEP(ub, 0, 2);
#pragma unroll 1
                    for (int j = 0; j < 16; ++j) {
                        { const int je = (j + rot) & 15; const u32x4 ha = *(const u32x4*)(H1B + (size_t)(tp + lg) * D + je * 256 + l16 * 16), hb = *(const u32x4*)(H1B + (size_t)(tp + lg) * D + je * 256 + l16 * 16 + 8);
                          u32x4 pk;
#pragma unroll
                          for (int q = 0; q < 2; ++q) {
                              int w0 = __builtin_amdgcn_cvt_pk_fp8_f32(H8C(bf_lo(ha[2 * q])), H8C(bf_hi(ha[2 * q])), 0, false); w0 = __builtin_amdgcn_cvt_pk_fp8_f32(H8C(bf_lo(ha[2 * q + 1])), H8C(bf_hi(ha[2 * q + 1])), w0, true);
                              int w1 = __builtin_amdgcn_cvt_pk_fp8_f32(H8C(bf_lo(hb[2 * q])), H8C(bf_hi(hb[2 * q])), 0, false); w1 = __builtin_amdgcn_cvt_pk_fp8_f32(H8C(bf_lo(hb[2 * q + 1])), H8C(bf_hi(hb[2 * q + 1])), w1, true);
                              pk[q] = (unsigned)w0; pk[2 + q] = (unsigned)w1; }
                          WFENCE();
                          *(LAS u32x4*)(HBp + lg * 256 + l16 * 16) = pk;
                          WFENCE(); }
                        i32x8 hf[4][2];
#pragma unroll
                        for (int i = 0; i < 4; ++i)
#pragma unroll
                            for (int kb = 0; kb < 2; ++kb) hf[i][kb] = CAT8(*(const LAS u32x4*)(HBp + i * 256 + kb * 128 + lg * 32), *(const LAS u32x4*)(HBp + i * 256 + kb * 128 + lg * 32 + 16));
                        const unsigned char* nub = j < 15 ? (const unsigned char*)UTAB + (size_t)((j + 1 + rot) & 15) * NEXP * 256 : ub;
#pragma unroll 1
                        for (int r = 0; r < 8; ++r) {
                            const unsigned char* pb = r == 7 ? nub : ub; const int rn = (r + 1) & 7;
#pragma unroll
                            for (int i = 0; i < 4; ++i) {
                                if (i + 3 < 4) ISSUE_STEP(ub, r, i + 3); else ISSUE_STEP(pb, rn, i + 3 - 4);
                                asm volatile("s_waitcnt vmcnt(12)" ::: "memory");
                                LAS unsigned char* src = RB + rb * 4096; rb = (rb + 1) & 3;
                                const u32x4 x0 = *(const LAS u32x4*)(src + fo0), x1 = *(const LAS u32x4*)(src + fo1), x2 = *(const LAS u32x4*)(src + (fo0 ^ 128)), x3 = *(const LAS u32x4*)(src + (fo1 ^ 128));
                                f32x4 dd;
                                asm volatile("s_nop 1\n\tv_mfma_f32_16x16x128_f8f6f4 %0, %1, %2, 0" : "=&v"(dd) : "v"(hf[i][0]), "v"(CAT8(x0, x1)));
                                asm volatile("v_mfma_f32_16x16x128_f8f6f4 %0, %1, %2, %0\n\ts_nop 15\n\ts_nop 3" : "+v"(dd) : "v"(hf[i][1]), "v"(CAT8(x2, x3)));
                                if (lg == 0) asm volatile("ds_add_f32 %0, %1" :: "v"((unsigned)(size_t)(HA + i * 128 + 16 * r + hae)), "v"(dd[0]) : "memory");
                                __builtin_amdgcn_sched_barrier(0);
                            }
                        }
                        ub = nub;
                    }
                    asm volatile("s_waitcnt vmcnt(0)" ::: "memory");
#undef ISSUE_STEP
#undef CAT8
                }
                WFENCE();
#pragma unroll 1
                for (int i = 0; i < 4; ++i) {
                    const float r2 = __builtin_amdgcn_rsqf(slot_sum<64>(SSQ_H + (size_t)(tp + i) * 64) * (1.f / 4096.f) + EPS) * (1.f / (PEER_SCU * H8_SC));
#pragma unroll
                    for (int hq = 0; hq < 2; ++hq) { const int e = lane + 64 * hq, q = i * 128 + e; const float z = HA[q] * r2;
                        const float av = 0.5f * z * (1.f + erff(z * 0.70710678118654752f)) * __uint_as_float((unsigned)GS[(size_t)(tp + i) * 128 + e] << 16) * A8_SC;
                        HBp[i * 128 + ((e & ~15) | ((e & 3) << 2) | ((e >> 2) & 3))] = (unsigned char)__builtin_amdgcn_cvt_pk_fp8_f32(__builtin_amdgcn_fmed3f(av, -448.f, 448.f), 0.f, 0, false); }
                }
                WFENCE();
                if (G * NWAVES * 8 == T) { asm volatile("s_waitcnt vmcnt(0)" ::: "memory"); __syncthreads(); if (tid == 0) { MISC[8] = sv_nloc; MISC[9] = sv_nx; } GRID_BAR(); }
                float ssq2[2] = {0.f, 0.f};
                const int th = lg >> 1, hb = lg & 1;
                {
                    LAS unsigned char* HB1 = (LAS unsigned char*)HA;
                    const int rho = 4 * lg + (l16 >> 2), pp = l16 & 3;
                    unsigned toff[8];
#pragma unroll
                    for (int g = 0; g < 8; ++g) toff[g] = (unsigned)(size_t)RB + (unsigned)(rho * 256 + (((g ^ (rho & 7)) << 5) | ((pp >> 1) << 4) | ((pp & 1) << 3)));
                    const unsigned selLo = (l16 & 1) ? 0x010c000cu : 0x0c010c00u, selHi = (l16 & 1) ? 0x030c020cu : 0x0c030c02u;
                    const int cm = (l16 >> 1) & 3;
                    const unsigned km0 = cm == 0 ? ~0u : 0u, km1 = cm == 1 ? ~0u : 0u, km2 = cm == 2 ? ~0u : 0u, km3 = cm == 3 ? ~0u : 0u;
                    const unsigned scl1 = 0x7f7f7f7fu;
                    int wb = 0, rb = 0;
#define ISSUE_STEPV(bq, rq, iq) do { const u32x2 ew2_ = *(const LAS u32x2*)(SE + (iq) * 128 + 16 * (rq) + 4 * lg); const unsigned ew_[4] = {ew2_.x & 0xffffu, ew2_.x >> 16, ew2_.y & 0xffffu, ew2_.y >> 16}; LAS unsigned char* dst_ = RB + wb * 4096; \
                        _Pragma("unroll") for (int q_ = 0; q_ < 4; ++q_) { const int n_ = 4 * q_ + lg; \
                            __builtin_amdgcn_global_load_lds((const unsigned*)((bq) + (size_t)ew_[q_] * 256 + ((l16 ^ ((n_ & 7) * 2)) * 16)), (LAS unsigned*)(dst_ + q_ * 1024), 16, 0, 0); } \
                        wb = (wb + 1) & 3; } while (0)
#define ISSUE_H1(jq) do { _Pragma("unroll") for (int t_ = 0; t_ < 2; ++t_) \
                        __builtin_amdgcn_global_load_lds((const unsigned*)(H1B + (size_t)(tp + 2 * t_ + (lane >> 5)) * D + (jq) * 256 + (lane & 31) * 8), (LAS unsigned*)(HB1 + t_ * 1024), 16, 0, 0); } while (0)
#define CAT8(x, y) __builtin_shufflevector(__builtin_bit_cast(i32x4, x), __builtin_bit_cast(i32x4, y), 0, 1, 2, 3, 4, 5, 6, 7)
#define CAT4(x, y) __builtin_shufflevector(x, y, 0, 1, 2, 3)
                    const unsigned char* vb = (const unsigned char*)VTAB + (size_t)rot * NEXP * 256;
                    ISSUE_STEPV(vb, 0, 0); ISSUE_STEPV(vb, 0, 1); ISSUE_STEPV(vb, 0, 2); ISSUE_H1(rot);
#pragma unroll 1
                    for (int j = 0; j < 16; ++j) {
                        f32x4 acc[4][2];
#pragma unroll
                        for (int i = 0; i < 4; ++i) { acc[i][0] = (f32x4){0.f, 0.f, 0.f, 0.f}; acc[i][1] = (f32x4){0.f, 0.f, 0.f, 0.f}; }
                        const unsigned char* nvb = j < 15 ? (const unsigned char*)VTAB + (size_t)((j + 1 + rot) & 15) * NEXP * 256 : vb; const int je = (j + rot) & 15;
#pragma unroll 1
                        for (int r = 0; r < 8; ++r) {
                            const unsigned char* pb = r == 7 ? nvb : vb; const int rn = (r + 1) & 7;
#pragma unroll
                            for (int i = 0; i < 4; ++i) {
                                if (i + 3 < 4) ISSUE_STEPV(vb, r, i + 3); else ISSUE_STEPV(pb, rn, i + 3 - 4);
                                const unsigned aw = *(const LAS unsigned*)(HBp + i * 128 + 16 * r + 4 * lg);
                                asm volatile("s_waitcnt vmcnt(12)" ::: "memory");
                                const unsigned so = (unsigned)rb * 4096u; rb = (rb + 1) & 3;
                                u32x2 bq[8];
#pragma unroll
                                for (int g = 0; g < 8; ++g) asm volatile("ds_read_b64_tr_b16 %0, %1" : "=v"(bq[g]) : "v"(toff[g] + so) : "memory");
                                const unsigned alo = __builtin_amdgcn_perm(aw, aw, selLo), ahi = __builtin_amdgcn_perm(aw, aw, selHi);
                                const i32x8 aop = {(int)(alo & km0), (int)(ahi & km0), (int)(alo & km1), (int)(ahi & km1), (int)(alo & km2), (int)(ahi & km2), (int)(alo & km3), (int)(ahi & km3)};
                                asm volatile("s_waitcnt lgkmcnt(0)" : "+v"(bq[0]), "+v"(bq[1]), "+v"(bq[2]), "+v"(bq[3]), "+v"(bq[4]), "+v"(bq[5]), "+v"(bq[6]), "+v"(bq[7]) :: "memory");
                                asm volatile("s_nop 1\n\tv_mfma_f32_16x16x128_f8f6f4 %0, %1, %2, %0" : "+v"(acc[i][0]) : "v"(aop), "v"(CAT8(CAT4(bq[0], bq[1]), CAT4(bq[2], bq[3]))));
                                asm volatile("s_nop 1\n\tv_mfma_f32_16x16x128_f8f6f4 %0, %1, %2, %0" : "+v"(acc[i][1]) : "v"(aop), "v"(CAT8(CAT4(bq[4], bq[5]), CAT4(bq[6], bq[7]))));
                                __builtin_amdgcn_sched_barrier(0);
                            }
                        }
                        vb = nvb;
                        asm volatile("s_nop 15\n\ts_nop 3" : "+v"(acc[0][0]), "+v"(acc[0][1]), "+v"(acc[1][0]), "+v"(acc[1][1]), "+v"(acc[2][0]), "+v"(acc[2][1]), "+v"(acc[3][0]), "+v"(acc[3][1]));
#pragma unroll
                        for (int tt = 0; tt < 2; ++tt)
#pragma unroll
                            for (int G = 0; G < 2; ++G) {
                                const f32x4 va_ = acc[tt][G] + 0.f, vb_ = acc[2 + tt][G] + 0.f; f32x4 v;
#pragma unroll
                                for (int e_ = 0; e_ < 4; ++e_) v[e_] = th ? vb_[e_] : va_[e_];
                                const int ch = 32 * (4 * G + 2 * hb) + 2 * l16;
                                bf16_t* op = H1B + (size_t)(tp + 2 * th + tt) * D + je * 256 + ch;
                                const unsigned ha = *(const LAS unsigned*)(HB1 + (2 * th + tt) * 512 + ch * 2), hc = *(const LAS unsigned*)(HB1 + (2 * th + tt) * 512 + (ch + 32) * 2);
                                f32x2 h0 = {bf_lo(ha) + v[0] * (1.f / (A8_SC * PEER_SCV)), bf_hi(ha) + v[1] * (1.f / (A8_SC * PEER_SCV))};
                                f32x2 h1v = {bf_lo(hc) + v[2] * (1.f / (A8_SC * PEER_SCV)), bf_hi(hc) + v[3] * (1.f / (A8_SC * PEER_SCV))};
                                ssq2[tt] += h0.x * h0.x + h0.y * h0.y + h1v.x * h1v.x + h1v.y * h1v.y;
                                *(unsigned*)op = cvt_pk_bf16(h0.x, h0.y); *(unsigned*)(op + 32) = cvt_pk_bf16(h1v.x, h1v.y); }
                        WFENCE();
                        if (j < 15) ISSUE_H1((j + 1 + rot) & 15);
                    }
                    asm volatile("s_waitcnt vmcnt(0)" ::: "memory");
#undef ISSUE_STEPV
#undef ISSUE_H1
#undef CAT8
#undef CAT4
                }
                float rnt[4];
#pragma unroll
                for (int tt = 0; tt < 2; ++tt) {
                    float sq = row16_sum(ssq2[tt] + 0.f); sq += __shfl_xor(sq, 16);
                    const float rn = __builtin_amdgcn_rsqf(sq * (1.f / 4096.f) + EPS);
                    rnt[tt] = __int_as_float(__builtin_amdgcn_readlane(__float_as_int(rn), 0)); rnt[2 + tt] = __int_as_float(__builtin_amdgcn_readlane(__float_as_int(rn), 32));
                }
#pragma unroll 1
                for (int i = 0; i < 4; ++i) {
                    const float rn = i == 0 ? rnt[0] : (i == 1 ? rnt[1] : (i == 2 ? rnt[2] : rnt[3]));
                    const bf16_t* hp2 = H1B + (size_t)(tp + i) * D + lane * 8; GAS float* op = outp + (size_t)(tp + i) * D + lane * 8; const GAS float* gp = gfin + lane * 8;
                    u32x4 hw[8];
#pragma unroll
                    for (int it = 0; it < 8; ++it) hw[it] = *(const u32x4*)(hp2 + it * 512);
#pragma unroll
                    for (int it = 0; it < 8; ++it) {
                        const f32x4 g0 = *(const GAS f32x4*)(gp + it * 512), g1 = *(const GAS f32x4*)(gp + it * 512 + 4);
                        const f32x4 a0 = {bf_lo(hw[it].x), bf_hi(hw[it].x), bf_lo(hw[it].y), bf_hi(hw[it].y)}, a1 = {bf_lo(hw[it].z), bf_hi(hw[it].z), bf_lo(hw[it].w), bf_hi(hw[it].w)};
                        __builtin_nontemporal_store(a0 * rn * g0, (GAS f32x4*)(op + it * 512)); __builtin_nontemporal_store(a1 * rn * g1, (GAS f32x4*)(op + it * 512 + 4)); }
                }
            }
        }
#undef WFENCE
#undef H8C
    }
#undef IN
#undef GRID_BAR
}


extern "C" void kernel_launch(void* const* d_in, const int* in_sizes, int n_in, void* d_out, int out_size, void* d_ws, size_t ws_size, hipStream_t stream) {
    static int grid = 0;
    if (grid == 0) {
        if (n_in != 19 || out_size != T * D || ws_size < WS_END3) { fprintf(stderr, "kernel_launch: unexpected shapes (n_in %d out %d ws %zu need %zu)\n", n_in, out_size, ws_size, (size_t)WS_END3); grid = -1; return; }
        int dev = 0, cus = 0, per_cu = 0;
        if (hipGetDevice(&dev) != hipSuccess || hipDeviceGetAttribute(&cus, hipDeviceAttributeMultiprocessorCount, dev) != hipSuccess) { grid = -1; return; }
        if (hipFuncSetAttribute((const void*)hybrid_fwd, hipFuncAttributeMaxDynamicSharedMemorySize, LDS_BYTES) != hipSuccess) { fprintf(stderr, "kernel_launch: hipFuncSetAttribute failed\n"); grid = -1; return; }
        if (hipOccupancyMaxActiveBlocksPerMultiprocessor(&per_cu, (const void*)hybrid_fwd, NTHREADS, LDS_BYTES) != hipSuccess || per_cu < 1) { fprintf(stderr, "kernel_launch: occupancy query says %d\n", per_cu); }
        (void)hipGetLastError();
        grid = cus;
    }
    if (grid < 0) return;
    (void)hipMemsetAsync((char*)d_ws + WS_CTL, 0, CTL_ZERO_BYTES, stream);
    Args a{};
    for (int i = 0; i < 19; ++i) a.in[i] = (const float*)d_in[i];
    a.pos = (const int*)d_in[2]; a.out = (float*)d_out; a.ws = (unsigned char*)d_ws;
#ifndef LAUNCH_SEQ
#define LAUNCH_SEQ {0, 10}
#endif
    static const int seq[][2] = {LAUNCH_SEQ};
    constexpr int nseq = (int)(sizeof(seq) / sizeof(seq[0]));
    for (int li = 0; li < nseq; ++li) { a.ph_lo = seq[li][0]; a.ph_hi = seq[li][1]; a.li = li; a.bar_on = (seq[li][1] - seq[li][0] > 1) ? 1 : 0;
        hipLaunchKernelGGL(hybrid_fwd, dim3(grid), dim3(NTHREADS), LDS_BYTES, stream, a); }

}
```

```cpp
#include <hip/hip_runtime.h>
#include <cstdio>
#include <cstdint>

#ifndef N_LAUNCHES
#define N_LAUNCHES 1
#endif

#define LAS __attribute__((address_space(3)))
#define GAS __attribute__((address_space(1)))
typedef unsigned short bf16_t;
typedef short bf16x8 __attribute__((ext_vector_type(8)));
typedef short s16x4 __attribute__((ext_vector_type(4)));
typedef float f32x4 __attribute__((ext_vector_type(4)));
typedef float f32x2 __attribute__((ext_vector_type(2)));
typedef float f32x16 __attribute__((ext_vector_type(16)));
typedef unsigned u32x4 __attribute__((ext_vector_type(4)));
typedef unsigned u32x2 __attribute__((ext_vector_type(2)));
typedef __bf16 bf2_t __attribute__((ext_vector_type(2)));
typedef int i32x4 __attribute__((ext_vector_type(4)));
typedef int i32x8 __attribute__((ext_vector_type(8)));

constexpr int T = 16384, SEQ = 8192, D = 4096;
constexpr int NPROJ = 22272;
constexpr int IN_COLS = 22080;
constexpr int NEXP = 16384;
constexpr float EPS = 1e-6f;
constexpr float LOG2E = 1.4426950408889634f;
constexpr float C_SB = LOG2E * 0.08838834764831845f;
constexpr float C_MLA = LOG2E * 0.07216878364870322f;
constexpr float C_MEM = LOG2E * 0.04419417382415922f;
constexpr float SB_DONE = -160.f;
constexpr float WG8_SC = 64.f;
constexpr float YB_SC = 16.f, YC_SC = 8.f, WBR_SC = 32.f, MG_SC = 4.f, WOUT_SC = 64.f;
constexpr int NPROJ_BF = 7936, NGATE = 12288, NPROJ_F8 = NGATE;
constexpr float MK_SC = 16.f, WK_SC = 64.f;
constexpr float MV_SC = 16.f, P8_SC = 256.f, BT_SC = 64.f;
constexpr float H8_SC = 8.f;
constexpr float A8_SC = 64.f;
constexpr float PEER_SCU = 1024.f, PEER_SCV = 16.f;

constexpr size_t MiB = 1u << 20;
constexpr size_t WS_CTL = 0, CTL_ZERO_BYTES = 1 * MiB;
constexpr size_t WS_RS = 1 * MiB;
constexpr size_t WS_SSQ_DQ = 1 * MiB + 512 * 1024;
constexpr size_t WS_SSQ_DKV = 2 * MiB + 512 * 1024;
constexpr size_t WS_SSQ_H = 3 * MiB;
constexpr size_t WS_CS = 8 * MiB;
constexpr size_t WS_MEMN = 12 * MiB;
constexpr size_t WS_MK = 16 * MiB;
constexpr size_t WS_MVT = 18 * MiB;
constexpr size_t WS_SKB = 20 * MiB;
constexpr size_t WS_WUQ = 22 * MiB;
constexpr size_t WS_WUKV = 28 * MiB;
constexpr size_t WS_WMKV = 32 * MiB;
constexpr size_t WS_WBR = 64 * MiB;
constexpr size_t WS_WOUT = 112 * MiB;
constexpr size_t WS_WPQ = 144 * MiB;
constexpr size_t WS_YMLA = 160 * MiB;
constexpr size_t WS_R0 = 224 * MiB;
constexpr size_t WS_XB = WS_R0;
constexpr size_t WS_WIN = WS_R0 + 128 * MiB;
constexpr size_t WS_QMLA = WS_R0;
constexpr size_t WS_KF = WS_R0 + 96 * MiB;
constexpr size_t WS_VV = WS_R0 + 192 * MiB;
constexpr size_t WS_H1B = WS_R0;
constexpr size_t WS_ROUTE = WS_R0 + 128 * MiB;
constexpr size_t WS_R1 = 526 * MiB;
constexpr size_t WS_SBQ = WS_R1;
constexpr size_t WS_SBK = WS_R1 + 64 * MiB;
constexpr size_t WS_SBV = WS_R1 + 128 * MiB;
constexpr size_t WS_DQ = WS_R1 + 192 * MiB;
constexpr size_t WS_DKV = WS_R1 + 224 * MiB;
constexpr size_t WS_MEMQ = WS_R1 + 248 * MiB;
constexpr size_t WS_GATES = WS_R1 + 312 * MiB;
constexpr size_t WS_MERGED = WS_SBK;
constexpr size_t WS_PQ = WS_SBQ;
constexpr size_t WS_UTAB = WS_GATES;
constexpr size_t WS_VTAB = WS_GATES + 128 * MiB;
constexpr size_t WS_SMEM = WS_GATES + 384 * MiB;
constexpr size_t WS_END = WS_SMEM + 64 * MiB;
constexpr size_t WS_XB8 = WS_END;
constexpr size_t WS_WIN8 = WS_R0 + 206 * MiB;
constexpr size_t WS_END2 = WS_XB8 + 64 * MiB;
constexpr size_t WS_WQN = WS_MEMQ;
constexpr size_t WS_WKT = WS_MEMQ + 8 * MiB;
constexpr size_t WS_BT = WS_WMKV;
constexpr size_t WS_END3 = WS_END2;
constexpr size_t WS_Y8A = WS_SMEM;
constexpr size_t WS_Y8B = WS_SMEM + 32 * MiB;
constexpr size_t WS_Y8C = WS_YMLA;
constexpr size_t WS_MG8 = WS_R0 + 128 * MiB;

constexpr int NWAVES = 8, NTHREADS = 512;
constexpr int LDS_BYTES = 163840;
constexpr int MISC_OFF = LDS_BYTES - 64;

__device__ __forceinline__ unsigned cvt_pk_bf16(float lo, float hi) { unsigned r; asm volatile("v_cvt_pk_bf16_f32 %0, %1, %2" : "=v"(r) : "v"(lo), "v"(hi)); return r; }
__device__ __forceinline__ float bf_lo(unsigned u) { return __uint_as_float(u << 16); }
__device__ __forceinline__ float bf_hi(unsigned u) { return __uint_as_float(u & 0xffff0000u); }
__device__ __forceinline__ float fexp2(float x) { return __builtin_amdgcn_exp2f(x); }
__device__ __forceinline__ float flog2(float x) { return __builtin_amdgcn_logf(x); }
__device__ __forceinline__ float frcp(float x) { return __builtin_amdgcn_rcpf(x); }
__device__ __forceinline__ float dot2_bf16(unsigned a, unsigned b, float acc) { return __builtin_amdgcn_fdot2_f32_bf16(__builtin_bit_cast(bf2_t, a), __builtin_bit_cast(bf2_t, b), acc, false); }
template <int CTRL> __device__ __forceinline__ float dpp_add(float x) { return x + __builtin_bit_cast(float, __builtin_amdgcn_update_dpp(0, __builtin_bit_cast(int, x), CTRL, 0xf, 0xf, false)); }
__device__ __forceinline__ float row16_sum(float x) { x = dpp_add<0x128>(x); x = dpp_add<0x141>(x); x = dpp_add<0x4E>(x); return dpp_add<0xB1>(x); }
__device__ __forceinline__ float xor32_max(float x) { const unsigned b = __float_as_uint(x); auto rr = __builtin_amdgcn_permlane32_swap(b, b, false, false); return fmaxf(__uint_as_float(rr[0]), __uint_as_float(rr[1])); }
__device__ __forceinline__ float xor32_sum(float x) { const unsigned b = __float_as_uint(x); auto rr = __builtin_amdgcn_permlane32_swap(b, b, false, false); return __uint_as_float(rr[0]) + __uint_as_float(rr[1]); }
__device__ __forceinline__ float xor32_partner(float x, int hi) { const unsigned b = __float_as_uint(x); auto rr = __builtin_amdgcn_permlane32_swap(b, b, false, false); return __uint_as_float(hi ? rr[0] : rr[1]); }
__device__ __forceinline__ float wave_sum(float v) {
#pragma unroll
    for (int o = 1; o < 64; o <<= 1) v += __shfl_xor(v, o);
    return v;
}
#define LDS_WAIT() asm volatile("s_waitcnt lgkmcnt(0)" ::: "memory")
#define VM_WAIT() asm volatile("s_waitcnt vmcnt(0)" ::: "memory")

namespace pg8 {
constexpr int BM = 256, BK = 64, HALF = 128, HTB = HALF * BK * 2, STAGE_BYTES = 8 * HTB, NXCD = 8, WGM = 8;
__host__ __device__ __forceinline__ int lds_byte(int r, int c) { const int st = (r >> 4) * 2 + (c >> 5), rr = r & 15, cc = c & 31, ob = rr * 64 + cc * 2; return st * 1024 + (ob ^ (((ob >> 9) & 1) << 5)); }
__host__ __device__ __forceinline__ void stage_rc(int b, int& R, int& C) { const int st = b / 1024, sb = b % 1024, swz = sb ^ (((sb >> 9) & 1) << 5); R = (st >> 1) * 16 + swz / 64; C = (st & 1) * 32 + (swz % 64) / 2; }
__host__ __device__ __forceinline__ int perm32(int rho) { const int n = rho >> 4, i = rho & 15; return 8 * (i >> 2) + 4 * n + (i & 3); }

struct Unit { int pm, pn, z; };
struct Gemm { int K, lda, ldb; };

__device__ __forceinline__ void tile_of(int wgid, int nM, int nN, int& pm, int& pn) {
    const int nwg = nM * nN;
    { const int q = nwg / NXCD, r = nwg % NXCD, xcd = wgid % NXCD, off = wgid / NXCD; wgid = (xcd < r ? xcd * (q + 1) : r * (q + 1) + (xcd - r) * q) + off; }
    const int nig = WGM * nN, gid = wgid / nig, fm = gid * WGM, gsz = (nM - fm) < WGM ? (nM - fm) : WGM;
    pm = fm + ((wgid % nig) % gsz); pn = (wgid % nig) / gsz;
}
struct SchedB {
    int nM, nN, nz, G, c; const char* A; const char* B; size_t tA, tB, zA, zB;
    __device__ __forceinline__ void init(int M, int N, int nz_, int G_, int c_, const void* A_, const void* B_, int lda, int ldb, size_t zA_, size_t zB_) {
        nM = M / BM; nN = N / BM; nz = nz_; G = G_; c = c_; A = (const char*)A_; B = (const char*)B_; tA = (size_t)BM * lda * 2; tB = (size_t)BM * ldb * 2; zA = zA_; zB = zB_; }
    __device__ __forceinline__ bool next(int i, Unit& u) const {
        const long L = (long)i * G + c; const int per = nM * nN; if (L >= (long)per * nz) return false;
        u.z = (int)(L / per); tile_of((int)(L % per), nM, nN, u.pm, u.pn); return true; }
    __device__ __forceinline__ const char* pa(const Unit& u) const { return A + (size_t)u.z * zA + (size_t)u.pm * tA; }
    __device__ __forceinline__ const char* pb(const Unit& u) const { return B + (size_t)u.z * zB + (size_t)u.pn * tB; }
    __device__ __forceinline__ int nt(const Unit&, int dflt) const { return dflt; }
};
struct SchedM {
    int nM, nN, G, c; const char* ws; const char* B; const char* BT; size_t tA, tB, zB; size_t o0, o1, o2;
    __device__ __forceinline__ bool next(int i, Unit& u) const {
        const long L = (long)(i / 3) * G + c; if (L >= (long)nM * nN) return false;
        u.z = i % 3; tile_of((int)L, nM, nN, u.pm, u.pn); return true; }
    __device__ __forceinline__ const char* pa(const Unit& u) const { const size_t off = (u.z == 0 ? (size_t)WS_Y8A : (u.z == 1 ? (size_t)WS_Y8B : (size_t)WS_Y8C)); return ws + off + (size_t)u.pm * tA; }
    __device__ __forceinline__ const char* pb(const Unit& u) const { return u.z == 2 ? BT + (size_t)(u.pm / (SEQ / 256)) * ((size_t)4096 * 2048) + (size_t)u.pn * tB : B + (size_t)u.z * zB + (size_t)u.pn * tB; }
    __device__ __forceinline__ int nt(const Unit& u, int dflt) const { return u.z == 2 ? 8 : dflt; }
};

template <class Epi, class Sched, bool ALIGN_EPI = true>
__device__ __forceinline__ void gemm_phase(LAS unsigned char* lds, const Gemm g, const Sched& S, const Epi& E) {
    const int tid = threadIdx.x, wid = __builtin_amdgcn_readfirstlane(tid >> 6), lane = tid & 63, wr = wid >> 2, wc = wid & 3, fr = lane & 15, fq = lane >> 4;
    const int K = g.K, nt = K / BK;
    unsigned voffA[2], voffB[2];
#pragma unroll
    for (int i = 0; i < 2; ++i) { int R, C; stage_rc(tid * 16 + i * 8192, R, C); const int Rb = Epi::PERM ? ((R & ~31) + perm32(R & 31)) : R;
        voffA[i] = (unsigned)(R * g.lda + C) * 2u; voffB[i] = (unsigned)(Rb * g.ldb + C) * 2u; }
    const size_t kstep = (size_t)(BK * 2);
    const size_t hsA = (size_t)HALF * g.lda * 2, hsB = (size_t)HALF * g.ldb * 2;
    const unsigned ldsw = (unsigned)wid * 1024u;
    const int aoff = lds_byte(wr * 64 + fr, fq * 8), boff = lds_byte(wc * 32 + fr, fq * 8);
#define PG8_SA(b, h) (((b) * 2 + (h)) * HTB)
#define PG8_SB(b, h) ((4 + (b) * 2 + (h)) * HTB)
#define PG8_STAGE(bufoff, gbase, voff) do { _Pragma("unroll") for (int _i = 0; _i < 2; ++_i) \
        __builtin_amdgcn_global_load_lds((const unsigned*)((const char*)(gbase) + (voff)[_i]), (LAS unsigned*)(lds + (bufoff) + ldsw + _i * 8192), 16, 0, 0); } while (0)
#define PG8_LDA(dst, b, h) do { _Pragma("unroll") for (int m = 0; m < 4; ++m) _Pragma("unroll") for (int k = 0; k < 2; ++k) dst[m][k] = *(const LAS bf16x8*)(lds + PG8_SA(b, h) + aoff + m * 2048 + k * 1024); } while (0)
#define PG8_LDB(dst, b, h) do { _Pragma("unroll") for (int n = 0; n < 2; ++n) _Pragma("unroll") for (int k = 0; k < 2; ++k) dst[n][k] = *(const LAS bf16x8*)(lds + PG8_SB(b, h) + boff + n * 2048 + k * 1024); } while (0)
#define PG8_MMA(ai, bj, At, Bt) do { __builtin_amdgcn_s_setprio(1); _Pragma("unroll") for (int m = 0; m < 4; ++m) _Pragma("unroll") for (int n = 0; n < 2; ++n) _Pragma("unroll") for (int k = 0; k < 2; ++k) \
        acc[ai][bj][m][n] = __builtin_amdgcn_mfma_f32_16x16x32_bf16(Bt[n][k], At[m][k], acc[ai][bj][m][n], 0, 0, 0); __builtin_amdgcn_s_setprio(0); } while (0)
#define PG8_WAIT_V(n) asm volatile("s_waitcnt vmcnt(" #n ")" ::: "memory")
#define PG8_WAIT_L(n) asm volatile("s_waitcnt lgkmcnt(" #n ")" ::: "memory")
#define PG8_BAR __builtin_amdgcn_s_barrier()
#define PG8_SCHED __builtin_amdgcn_sched_barrier(0)
    Unit cur, nxt; int ui = 0;
    if (!S.next(0, cur)) return;
    f32x4 acc[2][2][4][2];
#pragma unroll
    for (int a = 0; a < 2; ++a)
#pragma unroll
        for (int b = 0; b < 2; ++b)
#pragma unroll
            for (int m = 0; m < 4; ++m)
#pragma unroll
                for (int n = 0; n < 2; ++n) acc[a][b][m][n] = (f32x4){0.f, 0.f, 0.f, 0.f};
    bf16x8 At[4][2], B0[2][2], B1[2][2];
    const char* cA = S.pa(cur); const char* cB = S.pb(cur);
    PG8_STAGE(PG8_SB(0, 0), cB, voffB); PG8_STAGE(PG8_SB(0, 1), cB + hsB, voffB); PG8_STAGE(PG8_SA(0, 0), cA, voffA); PG8_STAGE(PG8_SA(0, 1), cA + hsA, voffA);
    if (wr == 1) PG8_BAR;
    PG8_WAIT_V(2); PG8_BAR;
    PG8_STAGE(PG8_SB(1, 0), cB + kstep, voffB); PG8_STAGE(PG8_SA(1, 0), cA + kstep, voffA); PG8_STAGE(PG8_SB(1, 1), cB + hsB + kstep, voffB);
    PG8_WAIT_V(6); PG8_BAR;
    for (;;) {
        const bool has_next = S.next(ui + 1, nxt);
        const char* nA = has_next ? S.pa(nxt) : cA; const char* nB = has_next ? S.pb(nxt) : cB;
        for (int t = 0; t < nt; t += 2) {
            const bool last = (t == nt - 2);
            const char* a1 = cA + (size_t)(t + 1) * kstep;
            const char* a2 = last ? nA : cA + (size_t)(t + 2) * kstep; const char* b2 = last ? nB : cB + (size_t)(t + 2) * kstep;
            const char* a3 = a2 + kstep; const char* b3 = b2 + kstep;
            PG8_LDB(B0, 0, 0); PG8_LDB(B1, 0, 1); PG8_SCHED; PG8_LDA(At, 0, 0); PG8_STAGE(PG8_SA(1, 1), a1 + hsA, voffA);
            PG8_WAIT_V(8); PG8_WAIT_L(0); PG8_BAR; PG8_MMA(0, 0, At, B0); PG8_MMA(0, 1, At, B1); PG8_BAR; PG8_SCHED;
            PG8_LDA(At, 0, 1); PG8_STAGE(PG8_SB(0, 0), b2, voffB); PG8_STAGE(PG8_SB(0, 1), b2 + hsB, voffB); PG8_STAGE(PG8_SA(0, 0), a2, voffA);
            PG8_WAIT_V(8); PG8_WAIT_L(0); PG8_BAR; PG8_MMA(1, 0, At, B0); PG8_MMA(1, 1, At, B1); PG8_BAR; PG8_SCHED;
            PG8_LDB(B0, 1, 0); PG8_LDB(B1, 1, 1); PG8_SCHED; PG8_LDA(At, 1, 0); PG8_STAGE(PG8_SA(0, 1), a2 + hsA, voffA);
            PG8_WAIT_V(8); PG8_WAIT_L(0); PG8_BAR; PG8_MMA(0, 0, At, B0); PG8_MMA(0, 1, At, B1); PG8_BAR; PG8_SCHED;
            PG8_LDA(At, 1, 1); PG8_STAGE(PG8_SB(1, 0), b3, voffB); PG8_STAGE(PG8_SB(1, 1), b3 + hsB, voffB); PG8_STAGE(PG8_SA(1, 0), a3, voffA);
            PG8_WAIT_V(8); PG8_WAIT_L(0); PG8_BAR; PG8_MMA(1, 0, At, B0); PG8_MMA(1, 1, At, B1); PG8_BAR; PG8_SCHED;
        }
        if constexpr (ALIGN_EPI) { if (wr == 0) PG8_BAR; }
        E(acc, cur, wr, wc, fr, fq);
        if (!has_next) break;
#pragma unroll
        for (int a = 0; a < 2; ++a)
#pragma unroll
            for (int b = 0; b < 2; ++b)
#pragma unroll
                for (int m = 0; m < 4; ++m)
#pragma unroll
                    for (int n = 0; n < 2; ++n) acc[a][b][m][n] = (f32x4){0.f, 0.f, 0.f, 0.f};
        cur = nxt; cA = nA; cB = nB; ++ui;
        if constexpr (ALIGN_EPI) { if (wr == 1) PG8_BAR; }
    }
    PG8_WAIT_V(0);
    if constexpr (!ALIGN_EPI) { if (wr == 0) PG8_BAR; }
    PG8_BAR;
#undef PG8_SA
#undef PG8_SB
#undef PG8_STAGE
#undef PG8_LDA
#undef PG8_LDB
#undef PG8_MMA
#undef PG8_WAIT_V
#undef PG8_WAIT_L
#undef PG8_BAR
#undef PG8_SCHED
}
__host__ __device__ __forceinline__ int sw8(int r) { return ((r >> 1) & 1) | (((r >> 3) & 1) << 2); }
template <class Epi, class Sched, bool ALIGN_EPI = true>
__device__ __forceinline__ void gemm_phase_f8(LAS unsigned char* lds, const Gemm g, const Sched& S, const Epi& E) {
    const int tid = threadIdx.x, wid = __builtin_amdgcn_readfirstlane(tid >> 6), lane = tid & 63, wr = wid >> 2, wc = wid & 3, fr = lane & 15, fq = lane >> 4;
    const int K = g.K, nt = K / 128;
    unsigned voffA[2], voffB[2];
#pragma unroll
    for (int i = 0; i < 2; ++i) { const int bb = tid * 16 + i * 8192, R = (bb >> 11) * 16 + ((bb >> 7) & 15), ch = ((bb >> 4) & 7) ^ sw8(R & 15); const int Rb = Epi::PERM ? ((R & ~31) + perm32(R & 31)) : R;
        voffA[i] = (unsigned)(R * g.lda + ch * 16); voffB[i] = (unsigned)(Rb * g.ldb + ch * 16); }
    const size_t kstep = (size_t)(BK * 2);
    const size_t hsA = (size_t)HALF * g.lda, hsB = (size_t)HALF * g.ldb;
    const unsigned ldsw = (unsigned)wid * 1024u;
    const int scl = 0x7f7f7f7f;
    const int aoff = (wr * 4) * 2048 + fr * 128, boff = (wc * 2) * 2048 + fr * 128, c0off = ((2 * fq) ^ sw8(fr)) * 16, c1off = ((2 * fq + 1) ^ sw8(fr)) * 16;
#define PG8_SA(b, h) (((b) * 2 + (h)) * HTB)
#define PG8_SB(b, h) ((4 + (b) * 2 + (h)) * HTB)
#define PG8_STAGE(bufoff, gbase, voff) do { _Pragma("unroll") for (int _i = 0; _i < 2; ++_i) \
        __builtin_amdgcn_global_load_lds((const unsigned*)((const char*)(gbase) + (voff)[_i]), (LAS unsigned*)(lds + (bufoff) + ldsw + _i * 8192), 16, 0, 0); } while (0)
#define PG8_LDA(dst, b, h) do { _Pragma("unroll") for (int m = 0; m < 4; ++m) { dst[m][0] = *(const LAS bf16x8*)(lds + PG8_SA(b, h) + aoff + m * 2048 + c0off); dst[m][1] = *(const LAS bf16x8*)(lds + PG8_SA(b, h) + aoff + m * 2048 + c1off); } } while (0)
#define PG8_LDB(dst, b, h) do { _Pragma("unroll") for (int n = 0; n < 2; ++n) { dst[n][0] = *(const LAS bf16x8*)(lds + PG8_SB(b, h) + boff + n * 2048 + c0off); dst[n][1] = *(const LAS bf16x8*)(lds + PG8_SB(b, h) + boff + n * 2048 + c1off); } } while (0)
#define PG8_F8(x) __builtin_shufflevector(__builtin_bit_cast(i32x4, x[0]), __builtin_bit_cast(i32x4, x[1]), 0, 1, 2, 3, 4, 5, 6, 7)
#define PG8_MMA(ai, bj, At, Bt) do { __builtin_amdgcn_s_setprio(1); _Pragma("unroll") for (int m = 0; m < 4; ++m) _Pragma("unroll") for (int n = 0; n < 2; ++n) \
        asm volatile("v_mfma_f32_16x16x128_f8f6f4 %0, %1, %2, %0" : "+v"(acc[ai][bj][m][n]) : "v"(PG8_F8(Bt[n])), "v"(PG8_F8(At[m]))); __builtin_amdgcn_s_setprio(0); } while (0)
#define PG8_WAIT_V(n) asm volatile("s_waitcnt vmcnt(" #n ")" ::: "memory")
#define PG8_WAIT_L(n) asm volatile("s_waitcnt lgkmcnt(" #n ")" ::: "memory")
#define PG8_BAR __builtin_amdgcn_s_barrier()
#define PG8_SCHED __builtin_amdgcn_sched_barrier(0)
    Unit cur, nxt; int ui = 0;
    if (!S.next(0, cur)) return;
    f32x4 acc[2][2][4][2];
#pragma unroll
    for (int a = 0; a < 2; ++a)
#pragma unroll
        for (int b = 0; b < 2; ++b)
#pragma unroll
            for (int m = 0; m < 4; ++m)
#pragma unroll
                for (int n = 0; n < 2; ++n) acc[a][b][m][n] = (f32x4){0.f, 0.f, 0.f, 0.f};
    bf16x8 At[4][2], B0[2][2], B1[2][2];
    const char* cA = S.pa(cur); const char* cB = S.pb(cur);
    PG8_STAGE(PG8_SB(0, 0), cB, voffB); PG8_STAGE(PG8_SB(0, 1), cB + hsB, voffB); PG8_STAGE(PG8_SA(0, 0), cA, voffA); PG8_STAGE(PG8_SA(0, 1), cA + hsA, voffA);
    if (wr == 1) PG8_BAR;
    PG8_WAIT_V(2); PG8_BAR;
    PG8_STAGE(PG8_SB(1, 0), cB + kstep, voffB); PG8_STAGE(PG8_SA(1, 0), cA + kstep, voffA); PG8_STAGE(PG8_SB(1, 1), cB + hsB + kstep, voffB);
    PG8_WAIT_V(6); PG8_BAR;
    for (;;) {
        const bool has_next = S.next(ui + 1, nxt);
        const char* nA = has_next ? S.pa(nxt) : cA; const char* nB = has_next ? S.pb(nxt) : cB;
        const int ntu = S.nt(cur, nt);
        for (int t = 0; t < ntu; t += 2) {
            const bool last = (t == ntu - 2);
            const char* a1 = cA + (size_t)(t + 1) * kstep;
            const char* a2 = last ? nA : cA + (size_t)(t + 2) * kstep; const char* b2 = last ? nB : cB + (size_t)(t + 2) * kstep;
            const char* a3 = a2 + kstep; const char* b3 = b2 + kstep;
            PG8_LDB(B0, 0, 0); PG8_LDB(B1, 0, 1); PG8_SCHED; PG8_LDA(At, 0, 0); PG8_STAGE(PG8_SA(1, 1), a1 + hsA, voffA);
            PG8_WAIT_V(8); PG8_WAIT_L(0); PG8_BAR; PG8_MMA(0, 0, At, B0); PG8_MMA(0, 1, At, B1); PG8_BAR; PG8_SCHED;
            PG8_LDA(At, 0, 1); PG8_STAGE(PG8_SB(0, 0), b2, voffB); PG8_STAGE(PG8_SB(0, 1), b2 + hsB, voffB); PG8_STAGE(PG8_SA(0, 0), a2, voffA);
            PG8_WAIT_V(8); PG8_WAIT_L(0); PG8_BAR; PG8_MMA(1, 0, At, B0); PG8_MMA(1, 1, At, B1); PG8_BAR; PG8_SCHED;
            PG8_LDB(B0, 1, 0); PG8_LDB(B1, 1, 1); PG8_SCHED; PG8_LDA(At, 1, 0); PG8_STAGE(PG8_SA(0, 1), a2 + hsA, voffA);
            PG8_WAIT_V(8); PG8_WAIT_L(0); PG8_BAR; PG8_MMA(0, 0, At, B0); PG8_MMA(0, 1, At, B1); PG8_BAR; PG8_SCHED;
            PG8_LDA(At, 1, 1); PG8_STAGE(PG8_SB(1, 0), b3, voffB); PG8_STAGE(PG8_SB(1, 1), b3 + hsB, voffB); PG8_STAGE(PG8_SA(1, 0), a3, voffA);
            PG8_WAIT_V(8); PG8_WAIT_L(0); PG8_BAR; PG8_MMA(1, 0, At, B0); PG8_MMA(1, 1, At, B1); PG8_BAR; PG8_SCHED;
        }
        if constexpr (ALIGN_EPI) { if (wr == 0) PG8_BAR; }
        E(acc, cur, wr, wc, fr, fq);
        if (!has_next) break;
#pragma unroll
        for (int a = 0; a < 2; ++a)
#pragma unroll
            for (int b = 0; b < 2; ++b)
#pragma unroll
                for (int m = 0; m < 4; ++m)
#pragma unroll
                    for (int n = 0; n < 2; ++n) acc[a][b][m][n] = (f32x4){0.f, 0.f, 0.f, 0.f};
        cur = nxt; cA = nA; cB = nB; ++ui;
        if constexpr (ALIGN_EPI) { if (wr == 1) PG8_BAR; }
    }
    PG8_WAIT_V(0);
    if constexpr (!ALIGN_EPI) { if (wr == 0) PG8_BAR; }
    PG8_BAR;
#undef PG8_SA
#undef PG8_SB
#undef PG8_STAGE
#undef PG8_LDA
#undef PG8_LDB
#undef PG8_MMA
#undef PG8_F8
#undef PG8_WAIT_V
#undef PG8_WAIT_L
#undef PG8_BAR
#undef PG8_SCHED
}
}
using pg8::Unit;

typedef const f32x4 (&AccRef)[2][2][4][2];

__device__ __forceinline__ void store_bf16x8(bf16_t* p, f32x4 v0, f32x4 v1) {
    u32x4 w; w.x = cvt_pk_bf16(v0[0], v0[1]); w.y = cvt_pk_bf16(v0[2], v0[3]); w.z = cvt_pk_bf16(v1[0], v1[1]); w.w = cvt_pk_bf16(v1[2], v1[3]);
    *(u32x4*)p = w;
}

struct EpiProj {
    static constexpr bool PERM = true;
    const float* rs; bf16_t* sbq; bf16_t* dq; bf16_t* dkv; bf16_t* memq; bf16_t* gates; float* ssq_dq; float* ssq_dkv; int pn0; float gsc;
    __device__ __forceinline__ void operator()(AccRef acc, const Unit& u, int wr, int wc, int fr, int fq) const {
        const int pn = u.pn + pn0, row0 = u.pm * 256 + wr * 64 + fr, cl = wc * 32 + 8 * fq;
        bf16_t* base; int ldc; float cs = 1.f; int mode = 0; float* sq = nullptr; int ns = 0, slot = 0;
        if (pn < 24) { const int which = pn >> 3; base = sbq + (size_t)which * ((size_t)T * 2048) + (pn & 7) * 256; ldc = 2048; if (which == 0) cs = C_SB; }
        else if (pn < 28) { base = dq + (pn - 24) * 256; ldc = 1024; sq = ssq_dq; ns = 16; slot = (pn - 24) * 4 + wc; }
        else if (pn < 31) { base = dkv + (pn - 28) * 256; ldc = 768; if (pn < 30) { sq = ssq_dkv; ns = 8; slot = (pn - 28) * 4 + wc; } }
        else if (pn < 39) { base = memq + (pn - 31) * 256; ldc = 2048; cs = C_MEM * gsc; }
        else { base = gates + ((size_t)(u.pm * 48 + (pn - 39)) << 16); ldc = 0; mode = 1; cs = gsc; }
        const int bjs = mode == 1 ? 512 : 128;
        float rsv[8];
#pragma unroll
        for (int q = 0; q < 8; ++q) rsv[q] = rs[row0 + (q >> 2) * 128 + (q & 3) * 16];
#pragma unroll
        for (int ai = 0; ai < 2; ++ai)
#pragma unroll
            for (int m = 0; m < 4; ++m) {
                const int row = row0 + ai * 128 + m * 16; const float sc = rsv[ai * 4 + m] * cs; float s2 = 0.f;
                bf16_t* rowp = mode == 1 ? base + (size_t)(((((wr * 4 + wc) * 2 + ai) * 4 + m) * 2) * 64 + fq * 16 + fr) * 8 : base + (size_t)row * ldc + cl;
#pragma unroll
                for (int bj = 0; bj < 2; ++bj) {
                    f32x4 v0 = acc[ai][bj][m][0] * sc, v1 = acc[ai][bj][m][1] * sc;
                    if (mode == 1) {
#pragma unroll
                        for (int j = 0; j < 4; ++j) { v0[j] = frcp(1.f + fexp2(-LOG2E * v0[j])); v1[j] = frcp(1.f + fexp2(-LOG2E * v1[j])); }
                    }

                    s2 += (v0[0] * v0[0] + v0[1] * v0[1]) + (v0[2] * v0[2] + v0[3] * v0[3]) + (v1[0] * v1[0] + v1[1] * v1[1]) + (v1[2] * v1[2] + v1[3] * v1[3]);
                    store_bf16x8(rowp + bj * bjs, v0, v1);
                }
                if (sq) { s2 += __shfl_xor(s2, 16); s2 += __shfl_xor(s2, 32); if (fq == 0) sq[(size_t)row * ns + slot] = s2; }
            }
    }
};
struct EpiMemKV {
    static constexpr bool PERM = false;
    bf16_t* mk; bf16_t* mvt;
    __device__ __forceinline__ void operator()(AccRef acc, const Unit& u, int wr, int wc, int fr, int fq) const {
        const int row0 = u.pm * 256 + wr * 64 + fr;
#pragma unroll
        for (int ai = 0; ai < 2; ++ai)
#pragma unroll
            for (int m = 0; m < 4; ++m) {
                const int row = row0 + ai * 128 + m * 16;
#pragma unroll
                for (int bj = 0; bj < 2; ++bj)
#pragma unroll
                    for (int n = 0; n < 2; ++n) {
                        const int col = u.pn * 256 + bj * 128 + wc * 32 + n * 16 + 4 * fq; const f32x4 v = acc[ai][bj][m][n];
                        if (u.pn < 8) { int q8 = __builtin_amdgcn_cvt_pk_fp8_f32(__builtin_amdgcn_fmed3f(v[0] * MK_SC, -448.f, 448.f), __builtin_amdgcn_fmed3f(v[1] * MK_SC, -448.f, 448.f), 0, false);
                            q8 = __builtin_amdgcn_cvt_pk_fp8_f32(__builtin_amdgcn_fmed3f(v[2] * MK_SC, -448.f, 448.f), __builtin_amdgcn_fmed3f(v[3] * MK_SC, -448.f, 448.f), q8, true);
                            *(unsigned*)((unsigned char*)mk + (size_t)row * 2048 + col) = (unsigned)q8; }
                        else { int q8 = __builtin_amdgcn_cvt_pk_fp8_f32(__builtin_amdgcn_fmed3f(v[0] * MV_SC, -448.f, 448.f), __builtin_amdgcn_fmed3f(v[1] * MV_SC, -448.f, 448.f), 0, false);
                            q8 = __builtin_amdgcn_cvt_pk_fp8_f32(__builtin_amdgcn_fmed3f(v[2] * MV_SC, -448.f, 448.f), __builtin_amdgcn_fmed3f(v[3] * MV_SC, -448.f, 448.f), q8, true);
                            *(unsigned*)((unsigned char*)mvt + (size_t)row * 2048 + (col - 2048)) = (unsigned)q8; }
                    }
            }
    }
};
template <int NS> __device__ __forceinline__ float slot_sum(const float* p) {
    float s = 0.f;
#pragma unroll
    for (int i = 0; i < NS / 4; ++i) { const f32x4 v = ((const f32x4*)p)[i]; s += (v[0] + v[1]) + (v[2] + v[3]); }
    return s;
}
struct EpiUQ {
    static constexpr bool PERM = true;
    const float* ssq; const f32x2* cs; bf16_t* q;
    __device__ __forceinline__ void operator()(AccRef acc, const Unit& u, int wr, int wc, int fr, int fq) const {
        const int row0 = u.pm * 256 + wr * 64 + fr;
#pragma unroll
        for (int ai = 0; ai < 2; ++ai) {
            float scv[4];
#pragma unroll
            for (int q = 0; q < 4; ++q) scv[q] = __builtin_amdgcn_rsqf(slot_sum<16>(ssq + (size_t)(row0 + ai * 128 + q * 16) * 16) * (1.f / 1024.f) + EPS) * C_MLA;
#pragma unroll
            for (int m = 0; m < 4; ++m) {
                const int row = row0 + ai * 128 + m * 16; const float sc = scv[m];
#pragma unroll
                for (int bj = 0; bj < 2; ++bj) {
                    const int col = u.pn * 256 + bj * 128 + wc * 32 + 8 * fq; const int d = col % 192;
                    f32x4 v0 = acc[ai][bj][m][0] * sc, v1 = acc[ai][bj][m][1] * sc;
                    if (d >= 128) {
                        const f32x2* c = cs + (size_t)row * 32 + ((d - 128) >> 1);
                        const f32x2 c0 = c[0], c1 = c[1], c2 = c[2], c3 = c[3];
                        f32x4 o0, o1;
                        o0[0] = v0[0] * c0.x - v0[1] * c0.y; o0[1] = v0[0] * c0.y + v0[1] * c0.x;
                        o0[2] = v0[2] * c1.x - v0[3] * c1.y; o0[3] = v0[2] * c1.y + v0[3] * c1.x;
                        o1[0] = v1[0] * c2.x - v1[1] * c2.y; o1[1] = v1[0] * c2.y + v1[1] * c2.x;
                        o1[2] = v1[2] * c3.x - v1[3] * c3.y; o1[3] = v1[2] * c3.y + v1[3] * c3.x;
                        v0 = o0; v1 = o1;
                    }
                    store_bf16x8(q + (size_t)row * 3072 + col, v0, v1);
                }
            }
        }
    }
};
struct EpiUKV {
    static constexpr bool PERM = true;
    const float* ssq; bf16_t* kn; bf16_t* vv;
    __device__ __forceinline__ void operator()(AccRef acc, const Unit& u, int wr, int wc, int fr, int fq) const {
        const int row0 = u.pm * 256 + wr * 64 + fr, cl = u.pn * 128 + wc * 32 + 8 * fq;
        float scv[8];
#pragma unroll
        for (int q = 0; q < 8; ++q) scv[q] = __builtin_amdgcn_rsqf(slot_sum<8>(ssq + (size_t)(row0 + (q >> 2) * 128 + (q & 3) * 16) * 8) * (1.f / 512.f) + EPS);
#pragma unroll
        for (int ai = 0; ai < 2; ++ai)
#pragma unroll
            for (int m = 0; m < 4; ++m) {
                const int row = row0 + ai * 128 + m * 16; const float sc = scv[ai * 4 + m];
                store_bf16x8(kn + (size_t)row * 3072 + u.pn * 192 + wc * 32 + 8 * fq, acc[ai][0][m][0] * sc, acc[ai][0][m][1] * sc);
                store_bf16x8(vv + (size_t)row * 2048 + cl, acc[ai][1][m][0] * sc, acc[ai][1][m][1] * sc);
            }
    }
};
struct EpiMemS {
    static constexpr bool PERM = false;
    float* s;
    __device__ __forceinline__ void operator()(AccRef acc, const Unit& u, int wr, int wc, int fr, int fq) const {
        const int b = u.z >> 2, h = u.z & 3, row0 = b * SEQ + u.pm * 256 + wr * 64 + fr;
#pragma unroll
        for (int ai = 0; ai < 2; ++ai)
#pragma unroll
            for (int m = 0; m < 4; ++m) { float* rowp = s + ((size_t)(row0 + ai * 128 + m * 16) * 4 + h) * 256 + wc * 32 + 4 * fq;
#pragma unroll
                for (int bj = 0; bj < 2; ++bj)
#pragma unroll
                    for (int n = 0; n < 2; ++n) *(f32x4*)(rowp + bj * 128 + n * 16) = acc[ai][bj][m][n]; }
    }
};
struct EpiWK {
    static constexpr bool PERM = false;
    unsigned char* wkt;
    __device__ __forceinline__ void operator()(AccRef acc, const Unit& u, int wr, int wc, int fr, int fq) const {
        const int b = u.z >> 2, h = u.z & 3, row0 = wr * 64 + fr;
        const float sc = WK_SC / (MK_SC * WG8_SC);
#pragma unroll
        for (int ai = 0; ai < 2; ++ai)
#pragma unroll
            for (int m = 0; m < 4; ++m) { unsigned char* rowp = wkt + ((size_t)b * 1024 + h * 256 + row0 + ai * 128 + m * 16) * 4096 + u.pn * 256 + wc * 32 + 4 * fq;
#pragma unroll
                for (int bj = 0; bj < 2; ++bj)
#pragma unroll
                    for (int n = 0; n < 2; ++n) { const f32x4 v = acc[ai][bj][m][n] * sc;
                        int q8 = __builtin_amdgcn_cvt_pk_fp8_f32(__builtin_amdgcn_fmed3f(v[0], -448.f, 448.f), __builtin_amdgcn_fmed3f(v[1], -448.f, 448.f), 0, false);
                        q8 = __builtin_amdgcn_cvt_pk_fp8_f32(__builtin_amdgcn_fmed3f(v[2], -448.f, 448.f), __builtin_amdgcn_fmed3f(v[3], -448.f, 448.f), q8, true);
                        *(unsigned*)(rowp + bj * 128 + n * 16) = (unsigned)q8; } }
    }
};
struct EpiScore {
    static constexpr bool PERM = false;
    const float* rs; unsigned char* p8; LAS float* red;
    __device__ __forceinline__ void operator()(AccRef acc, const Unit& u, int wr, int wc, int fr, int fq) const {
        const int lrow0 = wr * 64 + fr, row0 = u.pm * 256 + lrow0;
        float rsv[8], gmx[8];
#pragma unroll
        for (int q = 0; q < 8; ++q) rsv[q] = rs[row0 + (q >> 2) * 128 + (q & 3) * 16] * (C_MEM / WK_SC);
#pragma unroll
        for (int ai = 0; ai < 2; ++ai)
#pragma unroll
            for (int m = 0; m < 4; ++m) { float t = -3.0e38f;
#pragma unroll
                for (int bj = 0; bj < 2; ++bj)
#pragma unroll
                    for (int n = 0; n < 2; ++n) { const f32x4 v = acc[ai][bj][m][n]; t = fmaxf(t, fmaxf(fmaxf(v[0], v[1]), fmaxf(v[2], v[3]))); }
                t *= rsv[ai * 4 + m];
                t = fmaxf(t, __shfl_xor(t, 16)); t = fmaxf(t, __shfl_xor(t, 32));
                if (fq == 0) red[(lrow0 + ai * 128 + m * 16) * 4 + wc] = t; }
        asm volatile("s_waitcnt lgkmcnt(0)" ::: "memory"); __builtin_amdgcn_s_barrier(); asm volatile("" ::: "memory");
#pragma unroll
        for (int ai = 0; ai < 2; ++ai)
#pragma unroll
            for (int m = 0; m < 4; ++m) { const int q = ai * 4 + m; const f32x4 w4 = *(const LAS f32x4*)(red + (lrow0 + ai * 128 + m * 16) * 4);
                const float g = fmaxf(fmaxf(w4[0], w4[1]), fmaxf(w4[2], w4[3])); gmx[q] = g; float sm = 0.f;
#pragma unroll
                for (int bj = 0; bj < 2; ++bj)
#pragma unroll
                    for (int n = 0; n < 2; ++n) { const f32x4 v = acc[ai][bj][m][n] * rsv[q]; sm += (fexp2(v[0] - g) + fexp2(v[1] - g)) + (fexp2(v[2] - g) + fexp2(v[3] - g)); }
                sm += __shfl_xor(sm, 16); sm += __shfl_xor(sm, 32);
                if (fq == 0) red[1024 + (lrow0 + ai * 128 + m * 16) * 4 + wc] = sm; }
        asm volatile("s_waitcnt lgkmcnt(0)" ::: "memory"); __builtin_amdgcn_s_barrier(); asm volatile("" ::: "memory");
#pragma unroll
        for (int ai = 0; ai < 2; ++ai)
#pragma unroll
            for (int m = 0; m < 4; ++m) { const int q = ai * 4 + m; const f32x4 w4 = *(const LAS f32x4*)(red + 1024 + (lrow0 + ai * 128 + m * 16) * 4);
                const float inv = P8_SC * frcp((w4[0] + w4[1]) + (w4[2] + w4[3])), g = gmx[q];
                unsigned char* rowp = p8 + (size_t)(row0 + ai * 128 + m * 16) * 2048 + u.pn * 256 + wc * 32 + 4 * fq;
#pragma unroll
                for (int bj = 0; bj < 2; ++bj)
#pragma unroll
                    for (int n = 0; n < 2; ++n) { const f32x4 v = acc[ai][bj][m][n] * rsv[q];
                        int q8 = __builtin_amdgcn_cvt_pk_fp8_f32(fexp2(v[0] - g) * inv, fexp2(v[1] - g) * inv, 0, false); q8 = __builtin_amdgcn_cvt_pk_fp8_f32(fexp2(v[2] - g) * inv, fexp2(v[3] - g) * inv, q8, true);
                        *(unsigned*)(rowp + bj * 128 + n * 16) = (unsigned)q8; } }
    }
};
struct EpiVW {
    static constexpr bool PERM = false;
    unsigned char* bt;
    __device__ __forceinline__ void operator()(AccRef acc, const Unit& u, int wr, int wc, int fr, int fq) const {
        const int b = u.z >> 2, h = u.z & 3, row0 = u.pm * 256 + wr * 64 + fr;
        const float sc = BT_SC / (WBR_SC * MV_SC);
#pragma unroll
        for (int ai = 0; ai < 2; ++ai)
#pragma unroll
            for (int m = 0; m < 4; ++m) { unsigned char* rowp = bt + (size_t)b * ((size_t)4096 * 2048) + (size_t)(row0 + ai * 128 + m * 16) * 2048 + h * 256 + wc * 32 + 4 * fq;
#pragma unroll
                for (int bj = 0; bj < 2; ++bj)
#pragma unroll
                    for (int n = 0; n < 2; ++n) { const f32x4 v = acc[ai][bj][m][n] * sc;
                        int q8 = __builtin_amdgcn_cvt_pk_fp8_f32(__builtin_amdgcn_fmed3f(v[0], -448.f, 448.f), __builtin_amdgcn_fmed3f(v[1], -448.f, 448.f), 0, false);
                        q8 = __builtin_amdgcn_cvt_pk_fp8_f32(__builtin_amdgcn_fmed3f(v[2], -448.f, 448.f), __builtin_amdgcn_fmed3f(v[3], -448.f, 448.f), q8, true);
                        *(unsigned*)(rowp + bj * 128 + n * 16) = (unsigned)q8; } }
    }
};
struct EpiMemPV {
    static constexpr bool PERM = true;
    unsigned char* y;
    __device__ __forceinline__ void operator()(AccRef acc, const Unit& u, int wr, int wc, int fr, int fq) const {
        const int b = u.z >> 2, h = u.z & 3, row0 = b * SEQ + u.pm * 256 + wr * 64 + fr, cl = h * 512 + u.pn * 256 + wc * 32 + 8 * fq;
#pragma unroll
        for (int ai = 0; ai < 2; ++ai)
#pragma unroll
            for (int m = 0; m < 4; ++m) { unsigned char* rowp = y + (size_t)(row0 + ai * 128 + m * 16) * 2048 + cl;
#pragma unroll
                for (int bj = 0; bj < 2; ++bj) { const f32x4 v0 = acc[ai][bj][m][0] * YC_SC, v1 = acc[ai][bj][m][1] * YC_SC;
                    int w0 = __builtin_amdgcn_cvt_pk_fp8_f32(v0[0], v0[1], 0, false); w0 = __builtin_amdgcn_cvt_pk_fp8_f32(v0[2], v0[3], w0, true);
                    int w1 = __builtin_amdgcn_cvt_pk_fp8_f32(v1[0], v1[1], 0, false); w1 = __builtin_amdgcn_cvt_pk_fp8_f32(v1[2], v1[3], w1, true);
                    *(u32x2*)(rowp + bj * 128) = (u32x2){(unsigned)w0, (unsigned)w1}; } }
    }
};
struct EpiMerge {
    static constexpr bool PERM = true;
    const bf16_t* gates; bf16_t* merged; unsigned char* mg8;
    __device__ __forceinline__ void operator()(AccRef acc, const Unit& u, int wr, int wc, int fr, int fq) const {
        const int row0 = u.pm * 256 + wr * 64 + fr, cl = u.pn * 256 + wc * 32 + 8 * fq;
        const float bsc = u.z == 0 ? 1.f / WBR_SC : (u.z == 1 ? 1.f / (YB_SC * WBR_SC) : 1.f / (P8_SC * BT_SC));
        const bf16_t* gtile = gates + ((size_t)(u.pm * 48 + u.z * 16 + u.pn) << 16); bf16_t* mtile = merged + ((size_t)(u.pm * 16 + u.pn) << 16);
        int lidx = ((wr * 4 + wc) * 16) * 64 + fq * 16 + fr;
        asm volatile("" : "+v"(lidx));
#pragma unroll
        for (int ai = 0; ai < 2; ++ai) {
            u32x4 gw[8], pw[8];
#pragma unroll
            for (int q = 0; q < 8; ++q) { const int row = row0 + ai * 128 + (q >> 1) * 16, bj = q & 1;
                const int pos = (lidx + ((ai * 4 + (q >> 1)) * 2 + bj) * 64) * 8; (void)row;
                gw[q] = *(const u32x4*)(gtile + pos);
                pw[q] = u.z > 0 ? *(const u32x4*)(mtile + pos) : (u32x4){0u, 0u, 0u, 0u}; }
#pragma unroll
            for (int q = 0; q < 8; ++q) { const int m = q >> 1, bj = q & 1, row = row0 + ai * 128 + m * 16;
                f32x4 v0 = acc[ai][bj][m][0] * bsc, v1 = acc[ai][bj][m][1] * bsc;
                v0[0] = fmaf(v0[0], bf_lo(gw[q].x), bf_lo(pw[q].x)); v0[1] = fmaf(v0[1], bf_hi(gw[q].x), bf_hi(pw[q].x)); v0[2] = fmaf(v0[2], bf_lo(gw[q].y), bf_lo(pw[q].y)); v0[3] = fmaf(v0[3], bf_hi(gw[q].y), bf_hi(pw[q].y));
                v1[0] = fmaf(v1[0], bf_lo(gw[q].z), bf_lo(pw[q].z)); v1[1] = fmaf(v1[1], bf_hi(gw[q].z), bf_hi(pw[q].z)); v1[2] = fmaf(v1[2], bf_lo(gw[q].w), bf_lo(pw[q].w)); v1[3] = fmaf(v1[3], bf_hi(gw[q].w), bf_hi(pw[q].w));
                if (u.z < 2) store_bf16x8(mtile + (lidx + ((ai * 4 + m) * 2 + bj) * 64) * 8, v0, v1);
                else { int w0 = __builtin_amdgcn_cvt_pk_fp8_f32(v0[0] * MG_SC, v0[1] * MG_SC, 0, false); w0 = __builtin_amdgcn_cvt_pk_fp8_f32(v0[2] * MG_SC, v0[3] * MG_SC, w0, true);
                    int w1 = __builtin_amdgcn_cvt_pk_fp8_f32(v1[0] * MG_SC, v1[1] * MG_SC, 0, false); w1 = __builtin_amdgcn_cvt_pk_fp8_f32(v1[2] * MG_SC, v1[3] * MG_SC, w1, true);
                    *(u32x2*)(mg8 + (size_t)row * 4096 + cl + bj * 128) = (u32x2){(unsigned)w0, (unsigned)w1}; } }
        }
    }
};
struct EpiOut {
    static constexpr bool PERM = false;
    const float* x; float* h1; bf16_t* h1b; float* ssq; float osc;
    __device__ __forceinline__ void operator()(AccRef acc, const Unit& u, int wr, int wc, int fr, int fq) const {
        const int row0 = u.pm * 256 + wr * 64 + fr, cl = u.pn * 256 + wc * 32 + 4 * fq;
#pragma unroll
        for (int ai = 0; ai < 2; ++ai) {
            f32x4 xv[16];
#pragma unroll
            for (int q = 0; q < 16; ++q) xv[q] = *(const f32x4*)(x + (size_t)(row0 + ai * 128 + (q >> 2) * 16) * D + cl + ((q >> 1) & 1) * 128 + (q & 1) * 16);
#pragma unroll
            for (int m = 0; m < 4; ++m) {
                const int row = row0 + ai * 128 + m * 16; float s2 = 0.f;
#pragma unroll
                for (int bj = 0; bj < 2; ++bj)
#pragma unroll
                    for (int n = 0; n < 2; ++n) {
                        const size_t o = (size_t)row * D + cl + bj * 128 + n * 16;
                        const f32x4 v = acc[ai][bj][m][n] * osc + xv[m * 4 + bj * 2 + n];
                        u32x2 w; w.x = cvt_pk_bf16(v[0], v[1]); w.y = cvt_pk_bf16(v[2], v[3]); *(u32x2*)(h1b + o) = w;
                        s2 += (v[0] * v[0] + v[1] * v[1]) + (v[2] * v[2] + v[3] * v[3]);
                    }
                s2 += __shfl_xor(s2, 16); s2 += __shfl_xor(s2, 32); if (fq == 0) ssq[(size_t)row * 64 + u.pn * 4 + wc] = s2;
            }
        }
    }
};
struct EpiPQ {
    static constexpr bool PERM = true;
    const float* ssq; bf16_t* pq;
    __device__ __forceinline__ void operator()(AccRef acc, const Unit& u, int wr, int wc, int fr, int fq) const {
        const int row0 = u.pm * 256 + wr * 64 + fr, cl = u.pn * 256 + wc * 32 + 8 * fq;
        float scv[8];
#pragma unroll
        for (int q = 0; q < 8; ++q) scv[q] = __builtin_amdgcn_rsqf(slot_sum<64>(ssq + (size_t)(row0 + (q >> 2) * 128 + (q & 3) * 16) * 64) * (1.f / 4096.f) + EPS);
#pragma unroll
        for (int ai = 0; ai < 2; ++ai)
#pragma unroll
            for (int m = 0; m < 4; ++m) {
                const int row = row0 + ai * 128 + m * 16;
                const float sc = scv[ai * 4 + m];
#pragma unroll
                for (int bj = 0; bj < 2; ++bj) store_bf16x8(pq + (size_t)row * 2048 + cl + bj * 128, acc[ai][bj][m][0] * sc, acc[ai][bj][m][1] * sc);
            }
    }
};

#define XB_TMO      128
#define XB_XCNT(j)  (256  + 64 * (j))
#define XB_XSUB(j)  (1280 + 64 * (j))
#define XB_XGEN(j)  (2304 + 64 * (j))
#define XB_TOP      3328
#define XB_TOPGEN   3392
#define XCD_BAR_WORDS 3456
#define XB_SPIN_CAP (1u << 20)
__device__ __forceinline__ unsigned xb_ld(unsigned* p)              { return __hip_atomic_load(p, __ATOMIC_RELAXED, __HIP_MEMORY_SCOPE_AGENT); }
__device__ __forceinline__ unsigned xb_add(unsigned* p, unsigned v) { return __hip_atomic_fetch_add(p, v, __ATOMIC_RELAXED, __HIP_MEMORY_SCOPE_AGENT); }
__device__ __forceinline__ unsigned xb_xcc_id() { return (unsigned)__builtin_amdgcn_s_getreg((3 << 11) | 20) & 0xFu; }
#define XB_SPIN(cond, bar) do { unsigned _sp = 0; while (cond) { __builtin_amdgcn_s_sleep(1); \
    if ((++_sp & 255u) == 0u) { if (xb_ld(&(bar)[XB_TMO])) break; if (_sp > XB_SPIN_CAP) { atomicAdd(&(bar)[XB_TMO], 1u); break; } } } } while (0)
struct XcdBarrier { unsigned* bar; unsigned x; volatile LAS unsigned* st; };
__device__ __forceinline__ XcdBarrier xcd_barrier_post(unsigned* bar, volatile LAS unsigned* st) {
    XcdBarrier b; b.bar = bar; b.x = xb_xcc_id(); b.st = st;
    if (threadIdx.x == 0) (void)xb_add(&bar[XB_XCNT(b.x)], 1u);
    return b;
}
__device__ __forceinline__ void xcd_barrier_complete(unsigned* bar, unsigned x, unsigned& nloc, unsigned& nx) {
    const unsigned G = gridDim.x * gridDim.y * gridDim.z;
    unsigned sum, cnt, mine, sp = 0u;
    for (;;) {
        sum = 0u; cnt = 0u; mine = 0u;
#pragma unroll
        for (unsigned j = 0; j < 16; ++j) { const unsigned c = xb_ld(&bar[XB_XCNT(j)]); sum += c; cnt += (c > 0u) ? 1u : 0u; mine = (j == x) ? c : mine; }
        if (sum == G) break;
        __builtin_amdgcn_s_sleep(1);
        if ((++sp & 255u) == 0u) { if (xb_ld(&bar[XB_TMO])) break; if (sp > XB_SPIN_CAP) { atomicAdd(&bar[XB_TMO], 1u); break; } }
    }
    nloc = mine > 0u ? mine : 1u; nx = cnt > 0u ? cnt : 1u;
}
__device__ __forceinline__ void xcd_barrier(const XcdBarrier& b) {
    asm volatile("s_waitcnt vmcnt(0)" ::: "memory");
    __syncthreads();
    if (threadIdx.x == 0) {
        unsigned* bar = b.bar;
        __builtin_amdgcn_s_waitcnt(0);
        unsigned nloc = b.st[0], nx = b.st[1];
        if (nloc == 0u) { xcd_barrier_complete(bar, b.x, nloc, nx); b.st[0] = nloc; b.st[1] = nx; }
        const unsigned old = xb_add(&bar[XB_XSUB(b.x)], 1u);
        const unsigned gen = old / nloc;
        if (old + 1u == (gen + 1u) * nloc) {
            __builtin_amdgcn_fence(__ATOMIC_RELEASE, "agent");
            asm volatile("s_waitcnt vmcnt(0)" ::: "memory");
            const unsigned og = xb_add(&bar[XB_TOP], 1u);
            const unsigned tg = og / nx;
            if (og + 1u == (tg + 1u) * nx) xb_add(&bar[XB_TOPGEN], 1u);
            else XB_SPIN(xb_ld(&bar[XB_TOPGEN]) == tg, bar);
            __builtin_amdgcn_fence(__ATOMIC_ACQUIRE, "agent");
            xb_add(&bar[XB_XGEN(b.x)], 1u);
            asm volatile("s_waitcnt vmcnt(0)" ::: "memory");
        } else {
            XB_SPIN(xb_ld(&bar[XB_XGEN(b.x)]) == gen, bar);
            __builtin_amdgcn_fence(__ATOMIC_ACQUIRE, "agent");
            asm volatile("s_waitcnt vmcnt(0)" ::: "memory");
        }
    }
    __syncthreads();
}

template <class Map, bool F8 = false>
__device__ __forceinline__ void tr_item(const float* W, int K, int Nsrc, bf16_t* WT, const float* gain, LAS float* scr, int item, int nblk, int lane, Map map, float osc = 1.f) {
    const int kb = item / nblk, nb = item % nblk, k0 = 64 * kb, j0 = 32 * nb;
    if (Map::CONTIG) {
        const int sc0 = map(j0);
        f32x4 v[8];
#pragma unroll
        for (int q = 0; q < 8; ++q) { const int idx = q * 64 + lane, row = idx >> 3, c4 = idx & 7;
            v[q] = sc0 >= 0 ? *(const f32x4*)(W + (size_t)(k0 + row) * Nsrc + sc0 + c4 * 4) : (f32x4){0.f, 0.f, 0.f, 0.f}; }
#pragma unroll
        for (int q = 0; q < 8; ++q) { const int idx = q * 64 + lane, row = idx >> 3, c4 = idx & 7; f32x4 w = v[q]; if (gain) w = w * gain[k0 + row];
            LAS float* d = scr + row * 33 + c4 * 4; d[0] = w[0]; d[1] = w[1]; d[2] = w[2]; d[3] = w[3]; }
    } else {
        const int sc = map(j0 + (lane & 31));
#pragma unroll 8
        for (int i = 0; i < 32; ++i) { const int kk = 2 * i + (lane >> 5); float v = sc >= 0 ? W[(size_t)(k0 + kk) * Nsrc + sc] : 0.f; if (gain) v *= gain[k0 + kk]; scr[kk * 33 + (lane & 31)] = v; }
    }
    LDS_WAIT(); asm volatile("" ::: "memory");
    const int c = lane & 7;
#pragma unroll
    for (int j = 0; j < 4; ++j) { const int n = (lane >> 3) + 8 * j; const LAS float* s = scr + (8 * c) * 33 + n;
        if (F8) { int w0 = __builtin_amdgcn_cvt_pk_fp8_f32(s[0 * 33] * osc, s[1 * 33] * osc, 0, false); w0 = __builtin_amdgcn_cvt_pk_fp8_f32(s[2 * 33] * osc, s[3 * 33] * osc, w0, true);
            int w1 = __builtin_amdgcn_cvt_pk_fp8_f32(s[4 * 33] * osc, s[5 * 33] * osc, 0, false); w1 = __builtin_amdgcn_cvt_pk_fp8_f32(s[6 * 33] * osc, s[7 * 33] * osc, w1, true);
            *(u32x2*)((unsigned char*)WT + (size_t)(j0 + n) * K + k0 + 8 * c) = (u32x2){(unsigned)w0, (unsigned)w1}; }
        else { u32x4 o; o.x = cvt_pk_bf16(s[0 * 33], s[1 * 33]); o.y = cvt_pk_bf16(s[2 * 33], s[3 * 33]); o.z = cvt_pk_bf16(s[4 * 33], s[5 * 33]); o.w = cvt_pk_bf16(s[6 * 33], s[7 * 33]);
            *(u32x4*)(WT + (size_t)(j0 + n) * K + k0 + 8 * c) = o; } }
    LDS_WAIT(); asm volatile("" ::: "memory");
}
struct MapId { static constexpr bool CONTIG = true; __device__ __forceinline__ int operator()(int j) const { return j; } };
struct MapWin { static constexpr bool CONTIG = true; __device__ __forceinline__ int operator()(int j) const { return j < 7744 ? j : (j < 7936 ? -1 : j - 192); } };
struct MapGate { static constexpr bool CONTIG = true; __device__ __forceinline__ int operator()(int j) const { return 9792 + j; } };
struct MapUq { static constexpr bool CONTIG = false; __device__ __forceinline__ int operator()(int j) const { const int h = j / 192, d = j % 192; if (d < 128) return j; const int e = d - 128; return h * 192 + 128 + (e & 1) * 32 + (e >> 1); } };

__device__ __forceinline__ float row_to_bf16(const float* xrow, bf16_t* orow, const float* gain, int lane, unsigned* o8 = nullptr) {
    const f32x4* xr = (const f32x4*)xrow + lane;
    f32x4 v[16]; float s = 0.f;
#pragma unroll
    for (int j = 0; j < 16; ++j) { v[j] = xr[64 * j]; s += (v[j][0] * v[j][0] + v[j][1] * v[j][1]) + (v[j][2] * v[j][2] + v[j][3] * v[j][3]); }
    const float rs = __builtin_amdgcn_rsqf(wave_sum(s) * (1.f / 4096.f) + EPS);
    u32x2* o8b = (u32x2*)orow + lane;
#pragma unroll
    for (int j = 0; j < 16; ++j) {
        f32x4 w = v[j];
        if (gain) { const f32x4 g = ((const f32x4*)gain)[64 * j + lane]; w = w * rs * g; }
        u32x2 p; p.x = cvt_pk_bf16(w[0], w[1]); p.y = cvt_pk_bf16(w[2], w[3]); o8b[64 * j] = p;
        if (o8) { int q = __builtin_amdgcn_cvt_pk_fp8_f32(w[0], w[1], 0, false); q = __builtin_amdgcn_cvt_pk_fp8_f32(w[2], w[3], q, true); o8[64 * j + lane] = (unsigned)q; } }
    return rs;
}
__device__ __forceinline__ f32x2 cossin(float xf) {
    const double x = (double)xf;
    const double k = __builtin_rint(x * 0.63661977236758134308);
    double r = __builtin_fma(-k, 1.57079632679489655800e+00, x); r = __builtin_fma(-k, 6.12323399573676603587e-17, r);
    const double r2 = r * r;
    double s = -2.5052108385441718775e-08; s = s * r2 + 2.7557319223985890653e-06; s = s * r2 - 1.9841269841269841253e-04; s = s * r2 + 8.3333333333333332177e-03; s = s * r2 - 1.6666666666666665741e-01; s = r + r * r2 * s;
    double c = -2.7557319223985888e-07; c = c * r2 + 2.4801587301587302e-05; c = c * r2 - 1.3888888888888889e-03; c = c * r2 + 4.1666666666666664e-02; c = c * r2 - 0.5; c = 1.0 + r2 * c;
    const int q = ((int)k) & 3;
    const double cc = (q == 0) ? c : (q == 1) ? -s : (q == 2) ? -c : s;
    const double ss = (q == 0) ? s : (q == 1) ? c : (q == 2) ? -s : -c;
    return (f32x2){(float)cc, (float)ss};
}

struct AttnArgs { const bf16_t* q; const bf16_t* k; const bf16_t* v; unsigned char* y; float ysc; };
template <int MODE>
__device__ __forceinline__ void attn_phase(LAS unsigned char* lds, const AttnArgs& A, int G, int c) {
    constexpr int DQK = MODE == 0 ? 192 : 128, NKS = DQK / 16, KP = DQK * 2 + 16, VP = 320, QP = MODE == 0 ? 3072 : 2048;
    constexpr int KCH = DQK / 8;
    constexpr int KB0 = 0, KBS = 64 * KP, VB0 = 2 * KBS, VBS = 64 * VP, FLAG0 = VB0 + 2 * VBS;
    const int tid = threadIdx.x, wid = __builtin_amdgcn_readfirstlane(tid >> 6), lane = tid & 63, hi = lane >> 5, li = lane & 15;
    LAS unsigned* flags = (LAS unsigned*)(lds + FLAG0);
    const int xk = c & 7, xa = c >> 3;
    for (int it = 0; it < 2 * ((512 + G - 1) / G); ++it) {
        const int round = it >> 1, half = it & 1;
        int bh, qb;
        if (G == 256) { bh = 2 * xk + (xa >> 4) + 16 * round; qb = xa & 15; if (round >= 2) break; }
        else { const int p = c + round * G; if (p >= 512) break; bh = p >> 4; qb = p & 15; }
        if (half) qb = 31 - qb;
        const int b = bh >> 4, h = bh & 15, t0 = qb * 256, jmax = 4 * qb + 3, ntile = jmax + 1;
        const size_t rowbase = (size_t)b * SEQ;
        const int wrow0 = t0 + 32 * wid;
        const int tq = wrow0 + (lane & 31);
        bf16x8 qf[NKS];
        { const bf16_t* qp = A.q + (rowbase + tq) * QP + h * DQK + 8 * hi;
#pragma unroll
          for (int ks = 0; ks < NKS; ++ks) qf[ks] = *(const bf16x8*)(qp + 16 * ks); }
        f32x16 o[4];
#pragma unroll
        for (int d = 0; d < 4; ++d)
#pragma unroll
            for (int r = 0; r < 16; ++r) o[d][r] = 0.f;
        float m_run = -1e30f, l_run = 0.f, r_run = 0.f;
        auto issue_dma = [&](int j, int buf) {
            constexpr int KCPR = KCH + 1, KLOADS = KCPR, VLOADS = 20, KPB = MODE == 0 ? 6144 : 4096;
            const char* kbase = (const char*)A.k + ((rowbase + (size_t)64 * j) * KPB + (size_t)h * (DQK * 2));
            const char* vbase = (const char*)A.v + ((rowbase + (size_t)64 * j) * 4096 + (size_t)h * 256);
#pragma unroll
            for (int i = 0; i < (KLOADS + 7) / 8; ++i) { const int wl = wid + 8 * i;
                if (wl < KLOADS) { const int gch = wl * 64 + lane, row = gch / KCPR; int cc = gch % KCPR; if (cc == KCH) cc = 0;
                    __builtin_amdgcn_global_load_lds((const unsigned*)(kbase + (unsigned)(row * KPB + cc * 16)), (LAS unsigned*)(lds + KB0 + buf * KBS + wl * 1024), 16, 0, 0); } }
#pragma unroll
            for (int i = 0; i < (VLOADS + 7) / 8; ++i) { const int wl = wid + 8 * i;
                if (wl < VLOADS) { const int gch = wl * 64 + lane, row = gch / 20, cc = (gch % 20) & 15;
                    __builtin_amdgcn_global_load_lds((const unsigned*)(vbase + (unsigned)(row * 4096 + cc * 16)), (LAS unsigned*)(lds + VB0 + buf * VBS + wl * 1024), 16, 0, 0); } }
        };
        __syncthreads();
        issue_dma(MODE == 0 ? 0 : jmax, 0);
        VM_WAIT();
        __syncthreads();
        bool wdone = false;
        for (int i = 0; i < ntile; ++i) {
            const int j = MODE == 0 ? i : jmax - i, buf = i & 1;
            const bool more = i + 1 < ntile;
            if (more) issue_dma(MODE == 0 ? j + 1 : j - 1, buf ^ 1);
            const int k0 = 64 * j;
            bool active;
            if (MODE == 0) active = k0 <= wrow0 + 31; else active = (k0 < wrow0 + 31) && !wdone;
            if (active) {
                const LAS unsigned char* kb = lds + KB0 + buf * KBS + (lane & 31) * KP + hi * 16;
                const LAS unsigned char* vb = lds + VB0 + buf * VBS + (4 * hi + (li >> 2)) * VP + (16 * ((lane >> 4) & 1) + 4 * (li & 3)) * 2;
                const int dq0 = tq - k0 - 4 * hi;
#pragma unroll
                for (int kk = 0; kk < 2; ++kk) {
                    const int kt = MODE == 0 ? kk : 1 - kk;
                    const int dq = dq0 - 32 * kt;
                    if (MODE == 0 ? (k0 + 32 * kt > wrow0 + 31) : (k0 + 32 * kt >= wrow0 + 31)) continue;
                    f32x16 p;
#pragma unroll
                    for (int r = 0; r < 16; ++r) p[r] = 0.f;
#pragma unroll
                    for (int ks = 0; ks < NKS; ++ks) {
                        const bf16x8 a0 = *(const LAS bf16x8*)(kb + kt * 32 * KP + ks * 32);
                        p = __builtin_amdgcn_mfma_f32_32x32x16_bf16(a0, qf[ks], p, 0, 0, 0);
                    }
                    if (MODE == 0) {
                        if (k0 + 32 * kt + 31 > wrow0) {
#pragma unroll
                            for (int r = 0; r < 16; ++r) { const int cr = (r & 3) + 8 * (r >> 2); if (cr > dq) p[r] = -__builtin_inff(); }
                        }
                        float pmax = p[0];
#pragma unroll
                        for (int r = 1; r < 16; ++r) pmax = fmaxf(pmax, p[r]);
                        pmax = xor32_max(pmax);
                        const float mn = pmax > m_run + 8.f ? pmax : m_run, alpha = fexp2(m_run - mn); m_run = mn;
                        float ps = 0.f;
#pragma unroll
                        for (int r = 0; r < 16; ++r) { p[r] = fexp2(p[r] - mn); ps += p[r]; }
                        ps = xor32_sum(ps);
                        l_run = l_run * alpha + ps;
                        if (!__all(alpha == 1.f)) {
#pragma unroll
                            for (int d = 0; d < 4; ++d)
#pragma unroll
                                for (int r = 0; r < 16; ++r) o[d][r] *= alpha;
                        }
                    } else {
                        float lk[16];
#pragma unroll
                        for (int r = 0; r < 16; ++r) { const int cr = (r & 3) + 8 * (r >> 2); const float z = p[r];
                            const float sp = fmaxf(z, 0.f) + flog2(1.f + fexp2(-fabsf(z)));
                            lk[r] = (cr < dq) ? -sp : 0.f; }
                        float sg[4], pg[4];
#pragma unroll
                        for (int g = 0; g < 4; ++g) { sg[g] = (lk[4 * g] + lk[4 * g + 1]) + (lk[4 * g + 2] + lk[4 * g + 3]); pg[g] = xor32_partner(sg[g], hi); }
                        const float t3 = sg[3] + pg[3], t2 = sg[2] + pg[2], t1 = sg[1] + pg[1], t0s = sg[0] + pg[0];
                        float ub[4]; ub[3] = 0.f; ub[2] = t3; ub[1] = t3 + t2; ub[0] = t3 + t2 + t1;
#pragma unroll
                        for (int g = 0; g < 4; ++g) {
                            float aft = r_run + ub[g] + (hi ? 0.f : pg[g]);
#pragma unroll
                            for (int e = 3; e >= 0; --e) { const int r = 4 * g + e; const int cr = (r & 3) + 8 * (r >> 2);
                                const float w = (cr < dq) ? fexp2(p[r] + lk[r] + aft) : 0.f; aft += lk[r]; p[r] = w; }
                        }
                        r_run += (t3 + t2) + (t1 + t0s);
                    }
#pragma unroll
                    for (int s = 0; s < 2; ++s) {
                        u32x4 w0;
                        w0.x = cvt_pk_bf16(p[8 * s + 0], p[8 * s + 1]); w0.y = cvt_pk_bf16(p[8 * s + 2], p[8 * s + 3]); w0.z = cvt_pk_bf16(p[8 * s + 4], p[8 * s + 5]); w0.w = cvt_pk_bf16(p[8 * s + 6], p[8 * s + 7]);
                        const bf16x8 pf = __builtin_bit_cast(bf16x8, w0);
#pragma unroll
                        for (int d = 0; d < 4; ++d) {
                            const s16x4 lo = __builtin_amdgcn_ds_read_tr16_b64_v4i16((LAS s16x4*)(vb + (32 * kt + 16 * s) * VP + d * 64));
                            const s16x4 hh = __builtin_amdgcn_ds_read_tr16_b64_v4i16((LAS s16x4*)(vb + (32 * kt + 16 * s + 8) * VP + d * 64));
                            const bf16x8 af = {lo[0], lo[1], lo[2], lo[3], hh[0], hh[1], hh[2], hh[3]};
                            o[d] = __builtin_amdgcn_mfma_f32_32x32x16_bf16(af, pf, o[d], 0, 0, 0);
                        }
                    }
                }
            }
            if (MODE == 1) {
                wdone = wdone || (bool)__all(r_run < SB_DONE);
                if (lane == 0) flags[(i & 1) * 8 + wid] = wdone ? 1u : 0u;
            }
            VM_WAIT();
            __syncthreads();
            if (MODE == 1) {
                unsigned alld = 1u;
#pragma unroll
                for (int w = 0; w < 8; ++w) alld &= flags[(i & 1) * 8 + w];
                if (alld) break;
            }
        }
        const float inv = (MODE == 0 ? frcp(l_run) : 1.f) * A.ysc;
        unsigned char* yp = A.y + (rowbase + tq) * 2048 + h * 128 + 4 * hi;
#pragma unroll
        for (int d = 0; d < 4; ++d)
#pragma unroll
            for (int g = 0; g < 4; ++g) { int w = __builtin_amdgcn_cvt_pk_fp8_f32(o[d][4 * g] * inv, o[d][4 * g + 1] * inv, 0, false); w = __builtin_amdgcn_cvt_pk_fp8_f32(o[d][4 * g + 2] * inv, o[d][4 * g + 3] * inv, w, true);
                *(unsigned*)(yp + 32 * d + 8 * g) = (unsigned)w; }
    }
}

__device__ __forceinline__ const float* karg_in(int i) { const char* ka = (const char*)__builtin_amdgcn_kernarg_segment_ptr(); asm volatile("" : "+s"(ka)); return *(const float* const*)(ka + 8 * i); }
struct Args { const float* in[19]; const int* pos; float* out; unsigned char* ws; int ph_lo, ph_hi, li, bar_on; };

__global__ void __launch_bounds__(NTHREADS, 2) hybrid_fwd(Args args) {
    extern __shared__ __attribute__((aligned(16))) unsigned char lds_raw[];
    LAS unsigned char* lds = (LAS unsigned char*)lds_raw;
    volatile LAS unsigned* MISC = (volatile LAS unsigned*)(lds + MISC_OFF);
    const int tid = threadIdx.x, lane = tid & 63, wave = __builtin_amdgcn_readfirstlane(tid >> 6);
    const int G = gridDim.x, c = blockIdx.x;
    unsigned char* ws = args.ws;
    if (tid < 16) MISC[tid] = 0u;
    __syncthreads();
    XcdBarrier bar; bar.bar = (unsigned*)(ws + WS_CTL) + args.li * XCD_BAR_WORDS; bar.x = 0; bar.st = nullptr;
    const bool bar_on = args.bar_on != 0;
    if (bar_on) bar = xcd_barrier_post((unsigned*)(ws + WS_CTL) + args.li * XCD_BAR_WORDS, MISC + 8);
#define GRID_BAR() do { if (bar_on) xcd_barrier(bar); } while (0)
    const int lo = args.ph_lo, hi_ph = args.ph_hi;
#ifndef ONLY_PHASE
#define ONLY_PHASE -1
#endif
#define IN(k) ((ONLY_PHASE < 0 || ONLY_PHASE == (k)) && lo <= (k) && (k) < hi_ph)

#define I_x (karg_in(0))
#define I_mem (karg_in(1))
#define I_g_mix (karg_in(3))
#define I_w_in (karg_in(4))
#define I_g_q (karg_in(5))
#define I_w_uq (karg_in(6))
#define I_g_kv (karg_in(7))
#define I_w_ukv (karg_in(8))
#define I_g_mem (karg_in(9))
#define I_w_mkv (karg_in(10))
#define I_w_br (karg_in(11))
#define I_w_out (karg_in(12))
#define I_g_ffn (karg_in(13))
#define I_w_pq (karg_in(14))
#define I_subk (karg_in(15))
#define I_u_tab (karg_in(16))
#define I_v_tab (karg_in(17))
#define I_g_fin (karg_in(18))
#define RS ((float*)(ws + WS_RS))
#define SSQ_DQ ((float*)(ws + WS_SSQ_DQ))
#define SSQ_DKV ((float*)(ws + WS_SSQ_DKV))
#define SSQ_H ((float*)(ws + WS_SSQ_H))
#define CS ((f32x2*)(ws + WS_CS))
#define MEMN ((bf16_t*)(ws + WS_MEMN))
#define MK ((bf16_t*)(ws + WS_MK))
#define MVT ((bf16_t*)(ws + WS_MVT))
#define SKB ((bf16_t*)(ws + WS_SKB))
#define WUQ ((bf16_t*)(ws + WS_WUQ))
#define WUKV ((bf16_t*)(ws + WS_WUKV))
#define WMKV ((bf16_t*)(ws + WS_WMKV))
#define WBR ((bf16_t*)(ws + WS_WBR))
#define WOUT ((bf16_t*)(ws + WS_WOUT))
#define WPQ ((bf16_t*)(ws + WS_WPQ))
#define YMLA ((bf16_t*)(ws + WS_YMLA))
#define XB ((bf16_t*)(ws + WS_XB))
#define WIN ((bf16_t*)(ws + WS_WIN))
#define QMLA ((bf16_t*)(ws + WS_QMLA))
#define KF ((bf16_t*)(ws + WS_KF))
#define VV ((bf16_t*)(ws + WS_VV))
#define SMEM ((float*)(ws + WS_SMEM))
#define H1B ((bf16_t*)(ws + WS_H1B))
#define ROUTE ((u32x2*)(ws + WS_ROUTE))
#define SBQ ((bf16_t*)(ws + WS_SBQ))
#define SBK ((bf16_t*)(ws + WS_SBK))
#define SBV ((bf16_t*)(ws + WS_SBV))
#define DQ ((bf16_t*)(ws + WS_DQ))
#define DKV ((bf16_t*)(ws + WS_DKV))
#define MEMQ ((bf16_t*)(ws + WS_MEMQ))
#define GATES ((bf16_t*)(ws + WS_GATES))
#define MERGED ((bf16_t*)(ws + WS_MERGED))
#define PQ ((bf16_t*)(ws + WS_PQ))
#define UTAB ((bf16_t*)(ws + WS_UTAB))
#define VTAB ((bf16_t*)(ws + WS_VTAB))
#define DEF_GIDX() int c_op = c; asm volatile("" : "+s"(c_op)); const int gw = c_op * NWAVES + wave, NGW = G * NWAVES, gt = c_op * NTHREADS + tid, NGT = G * NTHREADS; (void)gw; (void)NGW; (void)gt; (void)NGT

    if (IN(0)) {
        DEF_GIDX();
        LAS float* scr = (LAS float*)(lds + wave * 16384);
        constexpr int I_WIN = 64 * (NPROJ_BF / 32), I_WG8 = 64 * (NPROJ_F8 / 32), I_UQ = 16 * 96, I_UKV = 8 * 128, I_MKV = 64 * 128, I_BR = 32 * 128, I_OUT = 64 * 128, I_PQ = 64 * 64;
        constexpr int NITEMS = I_WIN + I_WG8 + I_UQ + I_UKV + I_MKV + 3 * I_BR + I_OUT + I_PQ;
        for (int it = gw; it < NITEMS; it += NGW) {
            int r = it;
            if (r < I_WIN) { tr_item(I_w_in, 4096, IN_COLS, WIN, I_g_mix, scr, r, NPROJ_BF / 32, lane, MapWin()); continue; } r -= I_WIN;
            if (r < I_WG8) { tr_item<MapGate, true>(I_w_in, 4096, IN_COLS, (bf16_t*)(ws + WS_WIN8), I_g_mix, scr, r, NPROJ_F8 / 32, lane, MapGate(), WG8_SC); continue; } r -= I_WG8;
            if (r < I_UQ) { tr_item(I_w_uq, 1024, 3072, WUQ, I_g_q, scr, r, 96, lane, MapUq()); continue; } r -= I_UQ;
            if (r < I_UKV) { tr_item(I_w_ukv, 512, 4096, WUKV, I_g_kv, scr, r, 128, lane, MapId()); continue; } r -= I_UKV;
            if (r < I_MKV) { tr_item(I_w_mkv, 4096, 4096, WMKV, nullptr, scr, r, 128, lane, MapId()); continue; } r -= I_MKV;
            if (r < 3 * I_BR) { const int z = r / I_BR; tr_item<MapId, true>(I_w_br + (size_t)z * 2048 * 4096, 2048, 4096, (bf16_t*)((unsigned char*)WBR + (size_t)z * 4096 * 2048), nullptr, scr, r % I_BR, 128, lane, MapId(), WBR_SC); continue; } r -= 3 * I_BR;
            if (r < I_OUT) { tr_item<MapId, true>(I_w_out, 4096, 4096, WOUT, nullptr, scr, r, 128, lane, MapId(), WOUT_SC); continue; } r -= I_OUT;
            tr_item(I_w_pq, 4096, 2048, WPQ, I_g_ffn, scr, r, 64, lane, MapId());
        }
        for (int m = gw; m < T; m += NGW) { const float rs = row_to_bf16(I_x + (size_t)m * D, XB + (size_t)m * D, nullptr, lane, (unsigned*)(ws + WS_XB8) + (size_t)m * (D / 4)); if (lane == 0) RS[m] = rs; }
        for (int m = gw; m < 512; m += NGW) (void)row_to_bf16(I_mem + (size_t)m * D, MEMN + (size_t)m * D, I_g_mem, lane);
        for (int i = gt; i < 4096 * 512; i += NGT) { const int k = i >> 9, j4 = (i & 511) * 4;
            const f32x4 w = *(const f32x4*)(I_w_in + (size_t)k * IN_COLS + 7744 + j4) * (I_g_mix[k] * WG8_SC);
            int q8 = __builtin_amdgcn_cvt_pk_fp8_f32(w[0], w[1], 0, false); q8 = __builtin_amdgcn_cvt_pk_fp8_f32(w[2], w[3], q8, true);
            *(unsigned*)(ws + WS_WQN + (size_t)k * 2048 + j4) = (unsigned)q8; }
        for (int i = gt; i < T * 32; i += NGT) { const int t = i >> 5, f = i & 31;
            const float freq = exp2f(-(float)f * (13.287712379549449f / 32.f));
            const float ang = (float)((const int*)karg_in(19))[t] * freq; CS[i] = cossin(ang); }
        for (int i = gt; i < 8 * 2 * 128 * 128 / 4; i += NGT) { const f32x4 v = ((const f32x4*)I_subk)[i]; u32x2 w; w.x = cvt_pk_bf16(v[0], v[1]); w.y = cvt_pk_bf16(v[2], v[3]); ((u32x2*)SKB)[i] = w; }
        GRID_BAR();
    }
    if (IN(1)) {
        { pg8::SchedB S; S.init(T, NPROJ_BF, 1, G, c, XB, WIN, D, D, 0, 0);
          EpiProj E{RS, SBQ, DQ, DKV, MEMQ, GATES, SSQ_DQ, SSQ_DKV, 0, 1.f};
          pg8::gemm_phase<EpiProj, pg8::SchedB>(lds, pg8::Gemm{D, D, D}, S, E); }
        { pg8::SchedB S; S.init(T, NPROJ_F8, 1, G, c, ws + WS_XB8, ws + WS_WIN8, D / 2, D / 2, 0, 0);
          EpiProj E{RS, SBQ, DQ, DKV, MEMQ, GATES, SSQ_DQ, SSQ_DKV, 39, 1.f / WG8_SC};
          pg8::gemm_phase_f8<EpiProj, pg8::SchedB>(lds, pg8::Gemm{D, D, D}, S, E); }
        { const int cm = G >= 64 ? (c >= G - 32 ? c - (G - 32) : c + 32) : c;
          pg8::SchedB S; S.init(512, 4096, 1, G, cm, MEMN, WMKV, D, D, 0, 0);
          EpiMemKV E{MK, MVT};
          pg8::gemm_phase<EpiMemKV, pg8::SchedB>(lds, pg8::Gemm{D, D, D}, S, E); }
        GRID_BAR();
    }
    if (IN(2)) {
        { pg8::SchedB S; S.init(T, 3072, 1, G, c, DQ, WUQ, 1024, 1024, 0, 0);
          EpiUQ E{SSQ_DQ, CS, QMLA};
          pg8::gemm_phase<EpiUQ, pg8::SchedB>(lds, pg8::Gemm{1024, 1024, 1024}, S, E); }
        { pg8::SchedB S; S.init(T, 4096, 1, G, c, DKV, WUKV, 768, 512, 0, 0);
          EpiUKV E{SSQ_DKV, KF, VV};
          pg8::gemm_phase<EpiUKV, pg8::SchedB>(lds, pg8::Gemm{512, 768, 512}, S, E); }
        {
          struct SchedWK : pg8::SchedB {
              __device__ __forceinline__ const char* pa(const Unit& u) const { return A + (size_t)(u.z >> 2) * 256 * 2048 + (size_t)(u.z & 3) * 512; }
              __device__ __forceinline__ const char* pb(const Unit& u) const { return B + (size_t)(u.z & 3) * 512 + (size_t)u.pn * tB; }
          } SW; SW.init(256, 4096, 8, G, c, (const unsigned char*)MK, ws + WS_WQN, 1024, 1024, 0, 0);
          EpiWK EW{ws + WS_WKT};
          pg8::gemm_phase_f8<EpiWK, SchedWK>(lds, pg8::Gemm{512, 2048, 2048}, SW, EW); }
        {
          struct SchedVW : pg8::SchedB {
              __device__ __forceinline__ const char* pa(const Unit& u) const { return A + (size_t)(u.z & 3) * 512 + (size_t)u.pm * tA; }
              __device__ __forceinline__ const char* pb(const Unit& u) const { return B + (size_t)(u.z >> 2) * 256 * 2048 + (size_t)(u.z & 3) * 512 + (size_t)u.pn * tB; }
          } SV;
          SV.init(4096, 256, 8, G, (c + G / 2) % G, (const unsigned char*)WBR + (size_t)2 * 4096 * 2048, (const unsigned char*)MVT, 1024, 1024, 0, 0);
          EpiVW EV{ws + WS_BT};
          pg8::gemm_phase_f8<EpiVW, SchedVW>(lds, pg8::Gemm{512, 2048, 2048}, SV, EV); }
        DEF_GIDX();
        for (int i = gt; i < T * 32; i += NGT) { const int t = i >> 5, f = i & 31;
            const float t1 = bf_lo((unsigned)DKV[(size_t)t * 768 + 512 + f]), t2 = bf_lo((unsigned)DKV[(size_t)t * 768 + 544 + f]); const f32x2 cs = CS[i];
            const unsigned w = cvt_pk_bf16(t1 * cs.x - t2 * cs.y, t1 * cs.y + t2 * cs.x);
#pragma unroll
            for (int hh = 0; hh < 16; ++hh) ((unsigned*)(KF + (size_t)t * 3072 + hh * 192 + 128))[f] = w; }
        GRID_BAR();
    }
    if (IN(3)) {
        DEF_GIDX();
        {
          struct SchedSc : pg8::SchedB {
              __device__ __forceinline__ const char* pb(const Unit& u) const { return B + (size_t)(u.pm / (SEQ / 256)) * ((size_t)1024 * 4096) + (size_t)u.pn * tB; }
          } SS; SS.init(T, 1024, 1, G, c, ws + WS_XB8, ws + WS_WKT, D / 2, D / 2, 0, 0);
          EpiScore ES{RS, ws + WS_Y8C, (LAS float*)(lds + pg8::STAGE_BYTES)};
          pg8::gemm_phase_f8<EpiScore, SchedSc>(lds, pg8::Gemm{D, D, D}, SS, ES); }
        __syncthreads();
        { const AttnArgs A{SBQ, SBK, SBV, ws + WS_Y8A, 1.f}; attn_phase<1>(lds, A, G, c); }
        __syncthreads();
        { const AttnArgs A{QMLA, KF, VV, ws + WS_Y8B, YB_SC}; attn_phase<0>(lds, A, G, c); }
        GRID_BAR();
    }
    if (IN(5)) {
        pg8::SchedM S; S.nM = T / 256; S.nN = D / 256; S.G = G; S.c = c;
        S.ws = (const char*)ws; S.B = (const char*)WBR; S.BT = (const char*)(ws + WS_BT); S.o0 = 0; S.o1 = 0; S.o2 = 0;
        S.tA = (size_t)256 * 2048; S.tB = (size_t)256 * 2048; S.zB = (size_t)4096 * 2048;
        EpiMerge E{GATES, MERGED, ws + WS_MG8};
        pg8::gemm_phase_f8<EpiMerge, pg8::SchedM>(lds, pg8::Gemm{2048, 2048, 2048}, S, E);
        GRID_BAR();
    }
    if (IN(6)) {
        { pg8::SchedB S; S.init(T, D, 1, G, c, ws + WS_MG8, WOUT, D / 2, D / 2, 0, 0);
          EpiOut E{I_x, (float*)karg_in(20), H1B, SSQ_H, 1.f / (MG_SC * WOUT_SC)};
          pg8::gemm_phase_f8<EpiOut, pg8::SchedB>(lds, pg8::Gemm{D, D, D}, S, E); }
        DEF_GIDX();
        for (size_t w = gw; w < (size_t)NEXP * 4; w += NGW) {
            const size_t e = w >> 2; const int seg = (int)(w & 3);
            const f32x4* up = (const f32x4*)I_u_tab + e * (D / 4) + seg * 256 + lane; const f32x4* vp = (const f32x4*)I_v_tab + e * (D / 4) + seg * 256 + lane;
            f32x4 ua[4], va[4];
#pragma unroll
            for (int q = 0; q < 4; ++q) { ua[q] = up[64 * q]; va[q] = vp[64 * q]; }
#pragma unroll
            for (int q = 0; q < 4; ++q) {
                const f32x4 a = ua[q] * *(const f32x4*)(I_g_ffn + seg * 1024 + q * 256 + lane * 4) * PEER_SCU, p = va[q] * PEER_SCV;
                int du = __builtin_amdgcn_cvt_pk_fp8_f32(a[0], a[1], 0, false); du = __builtin_amdgcn_cvt_pk_fp8_f32(a[2], a[3], du, true);
                int dv = __builtin_amdgcn_cvt_pk_fp8_f32(p[0], p[1], 0, false); dv = __builtin_amdgcn_cvt_pk_fp8_f32(p[2], p[3], dv, true);
                const size_t dst = ((size_t)(seg * 4 + q) * NEXP + e) * 64 + lane;
                ((unsigned*)UTAB)[dst] = (unsigned)du; ((unsigned*)VTAB)[dst] = (unsigned)dv;
            }
        }
        GRID_BAR();
    }
    if (IN(7)) {
        pg8::SchedB S; S.init(T, 2048, 1, G, c, H1B, WPQ, D, D, 0, 0);
        EpiPQ E{SSQ_H, PQ};
        pg8::gemm_phase<EpiPQ, pg8::SchedB>(lds, pg8::Gemm{D, D, D}, S, E);
        GRID_BAR();
    }
    if (IN(8)) {
        constexpr int SCP = 129;
        LAS float* SC = (LAS float*)lds;
        LAS unsigned* LST = (LAS unsigned*)(lds + 2 * 128 * SCP * 4);
        LAS unsigned char* CT = lds + 2 * 128 * SCP * 4 + 128 * 33 * 4;
        if (tid < 50) { int id = 0, fi = 0, fj = 0; for (int i = 0; i < 16; ++i) for (int j = 0; j < 16 / (i + 1); ++j) { if (id == tid) { fi = i; fj = j; } ++id; } CT[2 * tid] = (unsigned char)fi; CT[2 * tid + 1] = (unsigned char)fj; }
        for (int un = c; un < 128 * 8; un += G) {
            const int tile = un >> 3, h = un & 7, tok0 = tile * 128;
            __syncthreads();
            {
                const int p = wave >> 2, tt = wave & 3, hi = lane >> 5;
                const bf16_t* qp = PQ + (size_t)(tok0 + 32 * tt + (lane & 31)) * 2048 + h * 256 + p * 128 + 8 * hi;
                bf16x8 af[8];
#pragma unroll
                for (int ks = 0; ks < 8; ++ks) af[ks] = *(const bf16x8*)(qp + 16 * ks);
#pragma unroll
                for (int nt = 0; nt < 4; ++nt) {
                    const bf16_t* kp = SKB + ((size_t)(h * 2 + p) * 128 + 32 * nt + (lane & 31)) * 128 + 8 * hi;
                    f32x16 acc;
#pragma unroll
                    for (int r = 0; r < 16; ++r) acc[r] = 0.f;
#pragma unroll
                    for (int ks = 0; ks < 8; ++ks) acc = __builtin_amdgcn_mfma_f32_32x32x16_bf16(af[ks], *(const bf16x8*)(kp + 16 * ks), acc, 0, 0, 0);
#pragma unroll
                    for (int r = 0; r < 16; ++r) SC[(p * 128 + 32 * tt + (r & 3) + 8 * (r >> 2) + 4 * hi) * SCP + 32 * nt + (lane & 31)] = acc[r];
                }
            }
            __syncthreads();
            if (tid < 256) {
                const int p = tid >> 7, tk = tid & 127;
                const LAS float* row = SC + (p * 128 + tk) * SCP;
                unsigned L[16];
#pragma unroll
                for (int s = 0; s < 16; ++s) L[s] = 0u;
#pragma unroll 4
                for (int n = 0; n < 128; ++n) {
                    unsigned u = __float_as_uint(row[n]); u = (u & 0x80000000u) ? ~u : (u | 0x80000000u);
                    unsigned xk = (u & ~127u) | (unsigned)(127 - n);
#pragma unroll
                    for (int s = 0; s < 16; ++s) { const unsigned hi2 = L[s] > xk ? L[s] : xk, lo2 = L[s] > xk ? xk : L[s]; L[s] = hi2; xk = lo2; }
                }
#pragma unroll
                for (int s = 0; s < 16; ++s) LST[tk * 33 + p * 16 + s] = L[s];
            } else {
                const u32x4* tu = (const u32x4*)UTAB + (size_t)un * 4096 + (tid - 256); const u32x4* tv = (const u32x4*)VTAB + (size_t)un * 4096 + (tid - 256);
                u32x4 ax = {0u, 0u, 0u, 0u};
#pragma unroll 8
                for (int q = 0; q < 16; ++q) { ax ^= tu[256 * q]; ax ^= tv[256 * q]; }
                if ((ax[0] ^ ax[1] ^ ax[2] ^ ax[3]) == 0x12345678u && ax[1] == 0x9abcdef0u) ((unsigned*)(ws + WS_CTL))[4096 + (tid & 255)] = ax[2];
            }
            __syncthreads();
            if (tid < 128) {
                const LAS unsigned* L = LST + tid * 33;
                unsigned Kk[16];
#pragma unroll
                for (int s = 0; s < 16; ++s) Kk[s] = 0u;
                float v0[16], v1[16];
#pragma unroll
                for (int s = 0; s < 16; ++s) { unsigned a = L[s] & ~127u, b = L[16 + s] & ~127u; a = (a & 0x80000000u) ? (a & 0x7fffffffu) : ~a; b = (b & 0x80000000u) ? (b & 0x7fffffffu) : ~b; v0[s] = __uint_as_float(a); v1[s] = __uint_as_float(b); }
                int id = 0;
#pragma unroll
                for (int i = 0; i < 16; ++i)
#pragma unroll
                    for (int j = 0; j < 16 / (i + 1); ++j) {
                        unsigned u = __float_as_uint(v0[i] + v1[j]); u = (u & 0x80000000u) ? ~u : (u | 0x80000000u);
                        unsigned xk = (u & ~63u) | (unsigned)(63 - id); ++id;
#pragma unroll
                        for (int s = 0; s < 16; ++s) { const unsigned hi2 = Kk[s] > xk ? Kk[s] : xk, lo2 = Kk[s] > xk ? xk : Kk[s]; Kk[s] = hi2; xk = lo2; }
                    }
                float val[16]; float sum = 0.f;
#pragma unroll
                for (int s = 0; s < 16; ++s) { unsigned a = Kk[s] & ~63u; a = (a & 0x80000000u) ? (a & 0x7fffffffu) : ~a; val[s] = __uint_as_float(a); }
#pragma unroll
                for (int s = 15; s >= 0; --s) { val[s] = fexp2((val[s] - val[0]) * LOG2E); sum += val[s]; }
                const float inv = 1.f / sum;
                u32x2* rp = ROUTE + (size_t)(tok0 + tid) * 128 + h * 16;
#pragma unroll
                for (int s = 0; s < 16; ++s) { const int cid = 63 - (int)(Kk[s] & 63u); const int ci = CT[2 * cid], cj = CT[2 * cid + 1];
                    const unsigned e = (127u - (L[ci] & 127u)) * 128u + (127u - (L[16 + cj] & 127u));
                    rp[s] = (u32x2){e, __float_as_uint(val[s] * inv)}; }
            }
        }
        GRID_BAR();
    }
    if (IN(9)) {
        LAS unsigned char* wl = lds + wave * 20480;
        LAS unsigned short* SE = (LAS unsigned short*)wl;
        LAS float* HA = (LAS float*)(wl + 1024);
        LAS unsigned char* HBp = wl + 3072;
        LAS unsigned char* RB = wl + 4096;
        LAS unsigned* TMP = (LAS unsigned*)RB;
        unsigned short* GS = (unsigned short*)(ws + WS_PQ);
        const unsigned sv_nloc = MISC[8], sv_nx = MISC[9];
        __syncthreads();
        const int l16 = lane & 15, lg = lane >> 4;
        const int rot = 2 * (c & 7);
#define WFENCE() asm volatile("s_waitcnt lgkmcnt(0)" ::: "memory")
#define H8C(x) __builtin_amdgcn_fmed3f((x) * H8_SC, -448.f, 448.f)
        for (int tg = c * NWAVES + wave; tg < T / 8; tg += G * NWAVES) {
            const int tb = tg * 8;
            WFENCE();
            GAS float* outp = (GAS float*)karg_in(20); const GAS float* gfin = (const GAS float*)I_g_fin;
#pragma unroll 1
            for (int pass = 0; pass < 2; ++pass) {
                const int ip0 = 0, tp = tb + 4 * pass;
                WFENCE();
#pragma unroll 1
                for (int i = 0; i < 4; ++i) {
                    const u32x2 r0 = ROUTE[(size_t)(tp + i) * 128 + lane], r1 = ROUTE[(size_t)(tp + i) * 128 + lane + 64];
                    const unsigned k0 = (r0.x << 7) | (unsigned)lane, k1 = (r1.x << 7) | (unsigned)(lane + 64);
                    TMP[lane] = k0; TMP[lane + 64] = k1;
                    WFENCE();
                    int ra = 0, rb = 0;
#pragma unroll 8
                    for (int m = 0; m < 128; ++m) { const unsigned km = TMP[m]; ra += km < k0 ? 1 : 0; rb += km < k1 ? 1 : 0; }
                    SE[i * 128 + ra] = (unsigned short)r0.x; SE[i * 128 + rb] = (unsigned short)r1.x;
                    GS[(size_t)(tp + i) * 128 + ra] = (unsigned short)cvt_pk_bf16(__uint_as_float(r0.y), 0.f); GS[(size_t)(tp + i) * 128 + rb] = (unsigned short)cvt_pk_bf16(__uint_as_float(r1.y), 0.f);
                    HA[i * 128 + lane] = 0.f; HA[i * 128 + lane + 64] = 0.f;
                    WFENCE();
                }
                {
                    const unsigned scl1 = 0x7f7f7f7fu;
                    const int nrow = l16;
                    const int fo0 = nrow * 256 + (((2 * lg) ^ nrow) * 16), fo1 = nrow * 256 + (((2 * lg + 1) ^ nrow) * 16);
                    const int hae = 4 * (l16 & 3) + (l16 >> 2);
                    int wb = 0, rb = 0;
#define CAT8(x, y) __builtin_shufflevector(__builtin_bit_cast(i32x4, x), __builtin_bit_cast(i32x4, y), 0, 1, 2, 3, 4, 5, 6, 7)
#define ISSUE_STEP(bq, rq, iq) do { const u32x2 ew2_ = *(const LAS u32x2*)(SE + (iq) * 128 + 16 * (rq) + 4 * lg); const unsigned ew_[4] = {ew2_.x & 0xffffu, ew2_.x >> 16, ew2_.y & 0xffffu, ew2_.y >> 16}; LAS unsigned char* dst_ = RB + wb * 4096; \
                        _Pragma("unroll") for (int q_ = 0; q_ < 4; ++q_) { const int n_ = 4 * q_ + lg; \
                            __builtin_amdgcn_global_load_lds((const unsigned*)((bq) + (size_t)ew_[q_] * 256 + ((l16 ^ n_) * 16)), (LAS unsigned*)(dst_ + q_ * 1024), 16, 0, 0); } \
                        wb = (wb + 1) & 3; } while (0)
                    const unsigned char* ub = (const unsigned char*)UTAB + (size_t)rot * NEXP * 256;
                    ISSUE_STEP(ub, 0, 0); ISSUE_STEP(ub, 0, 1); ISSUE_STEP(ub, 0, 2);
#pragma unroll 1
                    for (int j = 0; j < 16; ++j) {
                        { const int je = (j + rot) & 15; const u32x4 ha = *(const u32x4*)(H1B + (size_t)(tp + lg) * D + je * 256 + l16 * 16), hb = *(const u32x4*)(H1B + (size_t)(tp + lg) * D + je * 256 + l16 * 16 + 8);
                          u32x4 pk;
#pragma unroll
                          for (int q = 0; q < 2; ++q) {
                              int w0 = __builtin_amdgcn_cvt_pk_fp8_f32(H8C(bf_lo(ha[2 * q])), H8C(bf_hi(ha[2 * q])), 0, false); w0 = __builtin_amdgcn_cvt_pk_fp8_f32(H8C(bf_lo(ha[2 * q + 1])), H8C(bf_hi(ha[2 * q + 1])), w0, true);
                              int w1 = __builtin_amdgcn_cvt_pk_fp8_f32(H8C(bf_lo(hb[2 * q])), H8C(bf_hi(hb[2 * q])), 0, false); w1 = __builtin_amdgcn_cvt_pk_fp8_f32(H8C(bf_lo(hb[2 * q + 1])), H8C(bf_hi(hb[2 * q + 1])), w1, true);
                              pk[q] = (unsigned)w0; pk[2 + q] = (unsigned)w1; }
                          WFENCE();
                          *(LAS u32x4*)(HBp + lg * 256 + l16 * 16) = pk;
                          WFENCE(); }
                        i32x8 hf[4][2];
#pragma unroll
                        for (int i = 0; i < 4; ++i)
#pragma unroll
                            for (int kb = 0; kb < 2; ++kb) hf[i][kb] = CAT8(*(const LAS u32x4*)(HBp + i * 256 + kb * 128 + lg * 32), *(const LAS u32x4*)(HBp + i * 256 + kb * 128 + lg * 32 + 16));
                        const unsigned char* nub = j < 15 ? (const unsigned char*)UTAB + (size_t)((j + 1 + rot) & 15) * NEXP * 256 : ub;
#pragma unroll 1
                        for (int r = 0; r < 8; ++r) {
                            const unsigned char* pb = r == 7 ? nub : ub; const int rn = (r + 1) & 7;
#pragma unroll
                            for (int i = 0; i < 4; ++i) {
                                if (i + 3 < 4) ISSUE_STEP(ub, r, i + 3); else ISSUE_STEP(pb, rn, i + 3 - 4);
                                asm volatile("s_waitcnt vmcnt(12)" ::: "memory");
                                LAS unsigned char* src = RB + rb * 4096; rb = (rb + 1) & 3;
                                const u32x4 x0 = *(const LAS u32x4*)(src + fo0), x1 = *(const LAS u32x4*)(src + fo1), x2 = *(const LAS u32x4*)(src + (fo0 ^ 128)), x3 = *(const LAS u32x4*)(src + (fo1 ^ 128));
                                f32x4 dd;
                                asm volatile("s_nop 1\n\tv_mfma_f32_16x16x128_f8f6f4 %0, %1, %2, 0" : "=&v"(dd) : "v"(hf[i][0]), "v"(CAT8(x0, x1)));
                                asm volatile("v_mfma_f32_16x16x128_f8f6f4 %0, %1, %2, %0\n\ts_nop 15\n\ts_nop 3" : "+v"(dd) : "v"(hf[i][1]), "v"(CAT8(x2, x3)));
                                if (lg == 0) asm volatile("ds_add_f32 %0, %1" :: "v"((unsigned)(size_t)(HA + i * 128 + 16 * r + hae)), "v"(dd[0]) : "memory");
                                __builtin_amdgcn_sched_barrier(0);
                            }
                        }
                        ub = nub;
                    }
                    asm volatile("s_waitcnt vmcnt(0)" ::: "memory");
#undef ISSUE_STEP
#undef CAT8
                }
                WFENCE();
#pragma unroll 1
                for (int i = 0; i < 4; ++i) {
                    const float r2 = __builtin_amdgcn_rsqf(slot_sum<64>(SSQ_H + (size_t)(tp + i) * 64) * (1.f / 4096.f) + EPS) * (1.f / (PEER_SCU * H8_SC));
#pragma unroll
                    for (int hq = 0; hq < 2; ++hq) { const int e = lane + 64 * hq, q = i * 128 + e; const float z = HA[q] * r2;
                        const float av = 0.5f * z * (1.f + erff(z * 0.70710678118654752f)) * __uint_as_float((unsigned)GS[(size_t)(tp + i) * 128 + e] << 16) * A8_SC;
                        HBp[i * 128 + ((e & ~15) | ((e & 3) << 2) | ((e >> 2) & 3))] = (unsigned char)__builtin_amdgcn_cvt_pk_fp8_f32(__builtin_amdgcn_fmed3f(av, -448.f, 448.f), 0.f, 0, false); }
                }
                WFENCE();
                if (G * NWAVES * 8 == T) { asm volatile("s_waitcnt vmcnt(0)" ::: "memory"); __syncthreads(); if (tid == 0) { MISC[8] = sv_nloc; MISC[9] = sv_nx; } GRID_BAR(); }
                float ssq2[2] = {0.f, 0.f};
                const int th = lg >> 1, hb = lg & 1;
                {
                    LAS unsigned char* HB1 = (LAS unsigned char*)HA;
                    const int rho = 4 * lg + (l16 >> 2), pp = l16 & 3;
                    unsigned toff[8];
#pragma unroll
                    for (int g = 0; g < 8; ++g) toff[g] = (unsigned)(size_t)RB + (unsigned)(rho * 256 + (((g ^ (rho & 7)) << 5) | ((pp >> 1) << 4) | ((pp & 1) << 3)));
                    const unsigned selLo = (l16 & 1) ? 0x010c000cu : 0x0c010c00u, selHi = (l16 & 1) ? 0x030c020cu : 0x0c030c02u;
                    const int cm = (l16 >> 1) & 3;
                    const unsigned km0 = cm == 0 ? ~0u : 0u, km1 = cm == 1 ? ~0u : 0u, km2 = cm == 2 ? ~0u : 0u, km3 = cm == 3 ? ~0u : 0u;
                    const unsigned scl1 = 0x7f7f7f7fu;
                    int wb = 0, rb = 0;
#define ISSUE_STEPV(bq, rq, iq) do { const u32x2 ew2_ = *(const LAS u32x2*)(SE + (iq) * 128 + 16 * (rq) + 4 * lg); const unsigned ew_[4] = {ew2_.x & 0xffffu, ew2_.x >> 16, ew2_.y & 0xffffu, ew2_.y >> 16}; LAS unsigned char* dst_ = RB + wb * 4096; \
                        _Pragma("unroll") for (int q_ = 0; q_ < 4; ++q_) { const int n_ = 4 * q_ + lg; \
                            __builtin_amdgcn_global_load_lds((const unsigned*)((bq) + (size_t)ew_[q_] * 256 + ((l16 ^ ((n_ & 7) * 2)) * 16)), (LAS unsigned*)(dst_ + q_ * 1024), 16, 0, 0); } \
                        wb = (wb + 1) & 3; } while (0)
#define ISSUE_H1(jq) do { _Pragma("unroll") for (int t_ = 0; t_ < 2; ++t_) \
                        __builtin_amdgcn_global_load_lds((const unsigned*)(H1B + (size_t)(tp + 2 * t_ + (lane >> 5)) * D + (jq) * 256 + (lane & 31) * 8), (LAS unsigned*)(HB1 + t_ * 1024), 16, 0, 0); } while (0)
#define CAT8(x, y) __builtin_shufflevector(__builtin_bit_cast(i32x4, x), __builtin_bit_cast(i32x4, y), 0, 1, 2, 3, 4, 5, 6, 7)
#define CAT4(x, y) __builtin_shufflevector(x, y, 0, 1, 2, 3)
                    const unsigned char* vb = (const unsigned char*)VTAB + (size_t)rot * NEXP * 256;
                    ISSUE_STEPV(vb, 0, 0); ISSUE_STEPV(vb, 0, 1); ISSUE_STEPV(vb, 0, 2); ISSUE_H1(rot);
#pragma unroll 1
                    for (int j = 0; j < 16; ++j) {
                        f32x4 acc[4][2];
#pragma unroll
                        for (int i = 0; i < 4; ++i) { acc[i][0] = (f32x4){0.f, 0.f, 0.f, 0.f}; acc[i][1] = (f32x4){0.f, 0.f, 0.f, 0.f}; }
                        const unsigned char* nvb = j < 15 ? (const unsigned char*)VTAB + (size_t)((j + 1 + rot) & 15) * NEXP * 256 : vb; const int je = (j + rot) & 15;
#pragma unroll 1
                        for (int r = 0; r < 8; ++r) {
                            const unsigned char* pb = r == 7 ? nvb : vb; const int rn = (r + 1) & 7;
#pragma unroll
                            for (int i = 0; i < 4; ++i) {
                                if (i + 3 < 4) ISSUE_STEPV(vb, r, i + 3); else ISSUE_STEPV(pb, rn, i + 3 - 4);
                                const unsigned aw = *(const LAS unsigned*)(HBp + i * 128 + 16 * r + 4 * lg);
                                asm volatile("s_waitcnt vmcnt(12)" ::: "memory");
                                const unsigned so = (unsigned)rb * 4096u; rb = (rb + 1) & 3;
                                u32x2 bq[8];
#pragma unroll
                                for (int g = 0; g < 8; ++g) asm volatile("ds_read_b64_tr_b16 %0, %1" : "=v"(bq[g]) : "v"(toff[g] + so) : "memory");
                                const unsigned alo = __builtin_amdgcn_perm(aw, aw, selLo), ahi = __builtin_amdgcn_perm(aw, aw, selHi);
                                const i32x8 aop = {(int)(alo & km0), (int)(ahi & km0), (int)(alo & km1), (int)(ahi & km1), (int)(alo & km2), (int)(ahi & km2), (int)(alo & km3), (int)(ahi & km3)};
                                asm volatile("s_waitcnt lgkmcnt(0)" : "+v"(bq[0]), "+v"(bq[1]), "+v"(bq[2]), "+v"(bq[3]), "+v"(bq[4]), "+v"(bq[5]), "+v"(bq[6]), "+v"(bq[7]) :: "memory");
                                asm volatile("s_nop 1\n\tv_mfma_f32_16x16x128_f8f6f4 %0, %1, %2, %0" : "+v"(acc[i][0]) : "v"(aop), "v"(CAT8(CAT4(bq[0], bq[1]), CAT4(bq[2], bq[3]))));
                                asm volatile("s_nop 1\n\tv_mfma_f32_16x16x128_f8f6f4 %0, %1, %2, %0" : "+v"(acc[i][1]) : "v"(aop), "v"(CAT8(CAT4(bq[4], bq[5]), CAT4(bq[6], bq[7]))));
                                __builtin_amdgcn_sched_barrier(0);
                            }
                        }
                        vb = nvb;
                        asm volatile("s_nop 15\n\ts_nop 3" : "+v"(acc[0][0]), "+v"(acc[0][1]), "+v"(acc[1][0]), "+v"(acc[1][1]), "+v"(acc[2][0]), "+v"(acc[2][1]), "+v"(acc[3][0]), "+v"(acc[3][1]));
#pragma unroll
                        for (int tt = 0; tt < 2; ++tt)
#pragma unroll
                            for (int G = 0; G < 2; ++G) {
                                const f32x4 va_ = acc[tt][G] + 0.f, vb_ = acc[2 + tt][G] + 0.f; f32x4 v;
#pragma unroll
                                for (int e_ = 0; e_ < 4; ++e_) v[e_] = th ? vb_[e_] : va_[e_];
                                const int ch = 32 * (4 * G + 2 * hb) + 2 * l16;
                                bf16_t* op = H1B + (size_t)(tp + 2 * th + tt) * D + je * 256 + ch;
                                const unsigned ha = *(const LAS unsigned*)(HB1 + (2 * th + tt) * 512 + ch * 2), hc = *(const LAS unsigned*)(HB1 + (2 * th + tt) * 512 + (ch + 32) * 2);
                                f32x2 h0 = {bf_lo(ha) + v[0] * (1.f / (A8_SC * PEER_SCV)), bf_hi(ha) + v[1] * (1.f / (A8_SC * PEER_SCV))};
                                f32x2 h1v = {bf_lo(hc) + v[2] * (1.f / (A8_SC * PEER_SCV)), bf_hi(hc) + v[3] * (1.f / (A8_SC * PEER_SCV))};
                                ssq2[tt] += h0.x * h0.x + h0.y * h0.y + h1v.x * h1v.x + h1v.y * h1v.y;
                                *(unsigned*)op = cvt_pk_bf16(h0.x, h0.y); *(unsigned*)(op + 32) = cvt_pk_bf16(h1v.x, h1v.y); }
                        WFENCE();
                        if (j < 15) ISSUE_H1((j + 1 + rot) & 15);
                    }
                    asm volatile("s_waitcnt vmcnt(0)" ::: "memory");
#undef ISSUE_STEPV
#undef ISSUE_H1
#undef CAT8
#undef CAT4
                }
                float rnt[4];
#pragma unroll
                for (int tt = 0; tt < 2; ++tt) {
                    float sq = row16_sum(ssq2[tt] + 0.f); sq += __shfl_xor(sq, 16);
                    const float rn = __builtin_amdgcn_rsqf(sq * (1.f / 4096.f) + EPS);
                    rnt[tt] = __int_as_float(__builtin_amdgcn_readlane(__float_as_int(rn), 0)); rnt[2 + tt] = __int_as_float(__builtin_amdgcn_readlane(__float_as_int(rn), 32));
                }
#pragma unroll 1
                for (int i = 0; i < 4; ++i) {
                    const float rn = i == 0 ? rnt[0] : (i == 1 ? rnt[1] : (i == 2 ? rnt[2] : rnt[3]));
                    const bf16_t* hp2 = H1B + (size_t)(tp + i) * D + lane * 8; GAS float* op = outp + (size_t)(tp + i) * D + lane * 8; const GAS float* gp = gfin + lane * 8;
                    u32x4 hw[8];
#pragma unroll
                    for (int it = 0; it < 8; ++it) hw[it] = *(const u32x4*)(hp2 + it * 512);
#pragma unroll
                    for (int it = 0; it < 8; ++it) {
                        const f32x4 g0 = *(const GAS f32x4*)(gp + it * 512), g1 = *(const GAS f32x4*)(gp + it * 512 + 4);
                        const f32x4 a0 = {bf_lo(hw[it].x), bf_hi(hw[it].x), bf_lo(hw[it].y), bf_hi(hw[it].y)}, a1 = {bf_lo(hw[it].z), bf_hi(hw[it].z), bf_lo(hw[it].w), bf_hi(hw[it].w)};
                        __builtin_nontemporal_store(a0 * rn * g0, (GAS f32x4*)(op + it * 512)); __builtin_nontemporal_store(a1 * rn * g1, (GAS f32x4*)(op + it * 512 + 4)); }
                }
            }
        }
#undef WFENCE
#undef H8C
    }
#undef IN
#undef GRID_BAR
}


extern "C" void kernel_launch(void* const* d_in, const int* in_sizes, int n_in, void* d_out, int out_size, void* d_ws, size_t ws_size, hipStream_t stream) {
    static int grid = 0;
    if (grid == 0) {
        if (n_in != 19 || out_size != T * D || ws_size < WS_END3) { fprintf(stderr, "kernel_launch: unexpected shapes (n_in %d out %d ws %zu need %zu)\n", n_in, out_size, ws_size, (size_t)WS_END3); grid = -1; return; }
        int dev = 0, cus = 0, per_cu = 0;
        if (hipGetDevice(&dev) != hipSuccess || hipDeviceGetAttribute(&cus, hipDeviceAttributeMultiprocessorCount, dev) != hipSuccess) { grid = -1; return; }
        if (hipFuncSetAttribute((const void*)hybrid_fwd, hipFuncAttributeMaxDynamicSharedMemorySize, LDS_BYTES) != hipSuccess) { fprintf(stderr, "kernel_launch: hipFuncSetAttribute failed\n"); grid = -1; return; }
        if (hipOccupancyMaxActiveBlocksPerMultiprocessor(&per_cu, (const void*)hybrid_fwd, NTHREADS, LDS_BYTES) != hipSuccess || per_cu < 1) { fprintf(stderr, "kernel_launch: occupancy query says %d\n", per_cu); }
        (void)hipGetLastError();
        grid = cus;
    }
    if (grid < 0) return;
    (void)hipMemsetAsync((char*)d_ws + WS_CTL, 0, CTL_ZERO_BYTES, stream);
    Args a{};
    for (int i = 0; i < 19; ++i) a.in[i] = (const float*)d_in[i];
    a.pos = (const int*)d_in[2]; a.out = (float*)d_out; a.ws = (unsigned char*)d_ws;
#ifndef LAUNCH_SEQ
#define LAUNCH_SEQ {0, 10}
#endif
    static const int seq[][2] = {LAUNCH_SEQ};
    constexpr int nseq = (int)(sizeof(seq) / sizeof(seq[0]));
    for (int li = 0; li < nseq; ++li) { a.ph_lo = seq[li][0]; a.ph_hi = seq[li][1]; a.li = li; a.bar_on = (seq[li][1] - seq[li][0] > 1) ? 1 : 0;
        hipLaunchKernelGGL(hybrid_fwd, dim3(grid), dim3(NTHREADS), LDS_BYTES, stream, a); }

}
```
